# Optimizing an MI355X kernel written in HIP

```python
import jax, jax.numpy as jnp
from jax import lax
import numpy as np

D_MODEL = 2048
BATCH = 8
SEQ = 2048
DEPTH = 1

RET_HEADS = 8
RET_HEAD_DIM = 128
D_RET = RET_HEADS * RET_HEAD_DIM
CHUNK = 128
ROPE_BASE = 10000.0
D_CONV = D_MODEL // 2
CONV_K = 3
N_EXPERTS = 64
TOP_K = 8
N_GROUPS = 8
TOPK_GROUPS = 4
EXPERTS_PER_GROUP = N_EXPERTS // N_GROUPS
D_EXPERT = 512
D_SHARED = 512
ROUTED_SCALE = 2.5
MOE_BLOCK = 128
EPS = 1e-6
IN_SIZES = (D_RET, D_RET, D_RET, D_RET, D_CONV, D_CONV, D_CONV, D_MODEL, D_MODEL)
D_IN = sum(IN_SIZES)

kernel_name = "hybrid_retention_shortconv_moe_block"


def rms_norm(x, w):
    xf = x.astype(jnp.float32)
    y = xf * lax.rsqrt(jnp.mean(xf * xf, axis=-1, keepdims=True) + EPS)
    return (y * w.astype(jnp.float32)).astype(x.dtype)


def rotary(t):
    s, d = t.shape[1], t.shape[-1]
    half = d // 2
    inv = ROPE_BASE ** (-jnp.arange(half, dtype=jnp.float32) / half)
    ang = jnp.arange(s, dtype=jnp.float32)[:, None] * inv[None, :]
    cos, sin = jnp.cos(ang)[:, None, :], jnp.sin(ang)[:, None, :]
    t1, t2 = t[..., :half], t[..., half:]
    return jnp.concatenate([t1 * cos - t2 * sin, t1 * sin + t2 * cos], axis=-1)


def bidirectional_retention(q, k, v, decay_fwd, decay_bwd):
    b, s, h, d = q.shape
    n = s // CHUNK
    to_chunks = lambda t: t.reshape(b, n, CHUNK, h, d).transpose(0, 3, 1, 2, 4)
    q, k, v = to_chunks(q), to_chunks(k), to_chunks(v)
    lg_f = jax.nn.log_sigmoid(decay_fwd.astype(jnp.float32))
    lg_b = jax.nn.log_sigmoid(decay_bwd.astype(jnp.float32))
    pos = jnp.arange(CHUNK, dtype=jnp.float32)
    diff = pos[:, None] - pos[None, :]
    mask = jnp.where(diff >= 0,
                     jnp.exp(lg_f[:, None, None] * jnp.maximum(diff, 0.0)),
                     jnp.exp(lg_b[:, None, None] * jnp.maximum(-diff, 0.0)))
    scores = jnp.einsum('bhnid,bhnjd->bhnij', q, k) * mask[None, :, None]
    out = jnp.einsum('bhnij,bhnje->bhnie', scores, v).astype(jnp.float32)

    def chunk_scan(lg, key_w, reverse):
        kv = jnp.einsum('bhnjd,hj,bhnje->nbhde', k, key_w, v).astype(jnp.float32)
        decay = jnp.exp(lg * CHUNK)[None, :, None, None]

        def step(state, kv_n):
            return decay * state + kv_n, state
        _, states = lax.scan(step, jnp.zeros((b, h, d, d), jnp.float32), kv, reverse=reverse)
        return states

    st_f = chunk_scan(lg_f, jnp.exp(lg_f[:, None] * (CHUNK - 1.0 - pos)[None, :]), False)
    q_f = q * jnp.exp(lg_f[:, None] * (pos + 1.0)[None, :])[None, :, None, :, None]
    out = out + jnp.einsum('bhnid,nbhde->bhnie', q_f, st_f)
    st_b = chunk_scan(lg_b, jnp.exp(lg_b[:, None] * pos[None, :]), True)
    q_b = q * jnp.exp(lg_b[:, None] * (CHUNK - pos)[None, :])[None, :, None, :, None]
    out = out + jnp.einsum('bhnid,nbhde->bhnie', q_b, st_b)
    return out.transpose(0, 2, 3, 1, 4).reshape(b, s, h, d)


def token_mixer(h, w_in, decay_fwd, decay_bwd, ret_norm_w, w_ret_o, conv_w, w_conv_o, w_out):
    b, s, _ = h.shape
    proj = h @ w_in
    split_pts = np.cumsum(IN_SIZES)[:-1].tolist()
    q, k, v, g, cb, cc, cu, gate_r, gate_c = jnp.split(proj, split_pts, axis=-1)
    heads = lambda t: t.reshape(b, s, RET_HEADS, RET_HEAD_DIM)
    qh = rotary(heads(q))
    kh = rotary(heads(k)) * (RET_HEAD_DIM ** -0.5)
    o = bidirectional_retention(qh, kh, heads(v), decay_fwd, decay_bwd)
    o = rms_norm(o, ret_norm_w.reshape(RET_HEADS, RET_HEAD_DIM)).reshape(b, s, D_RET)
    y_ret = (jax.nn.silu(g) * o.astype(g.dtype)) @ w_ret_o
    u = cc * cu
    y = lax.conv_general_dilated(u, conv_w[:, None, :].astype(u.dtype), window_strides=(1,),
                                 padding=[(CONV_K // 2, CONV_K // 2)],
                                 dimension_numbers=('NWC', 'WIO', 'NWC'),
                                 feature_group_count=D_CONV)
    y_conv = (cb * y) @ w_conv_o
    merged = jax.nn.sigmoid(gate_r) * y_ret + jax.nn.sigmoid(gate_c) * y_conv
    return merged @ w_out


def swiglu(x, wg, wu, wd):
    return (jax.nn.silu(x @ wg) * (x @ wu)) @ wd


def moe_ffn(h, router_w, router_bias, w_gate, w_up, w_down, ws_gate, ws_up, ws_down):
    b, s, dm = h.shape
    t = b * s
    xf = h.reshape(t, dm)
    scores = jax.nn.sigmoid(jnp.dot(xf.astype(jnp.float32), router_w.astype(jnp.float32)))
    biased = scores + router_bias.astype(jnp.float32)
    grp_score = lax.top_k(biased.reshape(t, N_GROUPS, EXPERTS_PER_GROUP), 2)[0].sum(-1)
    _, grp_idx = lax.top_k(grp_score, TOPK_GROUPS)
    grp_mask = jnp.any(grp_idx[:, :, None] == jnp.arange(N_GROUPS)[None, None, :], axis=1)
    masked = jnp.where(jnp.repeat(grp_mask, EXPERTS_PER_GROUP, axis=1), biased, -jnp.inf)
    _, top_idx = lax.top_k(masked, TOP_K)
    top_s = jnp.take_along_axis(scores, top_idx, axis=1)
    top_w = top_s / jnp.sum(top_s, axis=-1, keepdims=True) * ROUTED_SCALE

    tk = t * TOP_K
    flat_e = top_idx.reshape(tk)
    flat_tok = jnp.arange(tk, dtype=jnp.int32) // TOP_K
    flat_w = top_w.reshape(tk)
    order = jnp.argsort(flat_e)
    se, stok, sw = flat_e[order], flat_tok[order], flat_w[order]
    counts = jnp.bincount(flat_e, length=N_EXPERTS)
    padded = (counts + MOE_BLOCK - 1) // MOE_BLOCK * MOE_BLOCK
    pad_end = jnp.cumsum(padded)
    pad_start = pad_end - padded
    start = jnp.cumsum(counts) - counts
    dest = pad_start[se] + (jnp.arange(tk) - start[se])
    cap = tk + N_EXPERTS * MOE_BLOCK
    n_blocks = cap // MOE_BLOCK
    buf_tok = jnp.zeros((cap,), jnp.int32).at[dest].set(stok)
    buf_w = jnp.zeros((cap,), jnp.float32).at[dest].set(sw)
    blk_e = jnp.minimum(jnp.searchsorted(pad_end, jnp.arange(n_blocks) * MOE_BLOCK, side='right'),
                        N_EXPERTS - 1)

    def expert_block(args):
        tok, wgt, e = args
        xb = xf[tok]
        return swiglu(xb, w_gate[e], w_up[e], w_down[e]) * wgt[:, None].astype(xb.dtype)

    out = lax.map(expert_block, (buf_tok.reshape(n_blocks, MOE_BLOCK),
                                 buf_w.reshape(n_blocks, MOE_BLOCK), blk_e))
    routed = jax.ops.segment_sum(out.reshape(cap, dm), buf_tok, num_segments=t)
    shared = swiglu(xf, ws_gate, ws_up, ws_down)
    return (routed + shared).reshape(b, s, dm)


def setup_inputs(seed: int = 0) -> dict:
    key = jax.random.key(seed)
    ks = jax.random.split(key, 24)
    f32 = jnp.float32
    nrm = lambda k, shape, fan_in, gain=1.0: jax.random.normal(k, shape, f32) * (gain * fan_in ** -0.5)
    L = DEPTH
    gam = 1.0 - 2.0 ** (-5.0 - jnp.arange(RET_HEADS, dtype=f32))
    logit_gam = jnp.log(gam) - jnp.log1p(-gam)
    return {
        "x": jax.random.normal(ks[0], (BATCH, SEQ, D_MODEL), f32),
        "c": jax.random.normal(ks[1], (BATCH, D_MODEL), f32),
        "w_ada": nrm(ks[2], (L, D_MODEL, 6 * D_MODEL), D_MODEL, 0.5),
        "b_ada": 0.02 * jax.random.normal(ks[3], (L, 6 * D_MODEL), f32),
        "norm1_w": 1.0 + 0.02 * jax.random.normal(ks[4], (L, D_MODEL), f32),
        "w_in": nrm(ks[5], (L, D_MODEL, D_IN), D_MODEL),
        "ret_decay_fwd": logit_gam[None] + 0.1 * jax.random.normal(ks[6], (L, RET_HEADS), f32),
        "ret_decay_bwd": logit_gam[None] + 0.1 * jax.random.normal(ks[7], (L, RET_HEADS), f32),
        "ret_norm_w": 1.0 + 0.02 * jax.random.normal(ks[8], (L, D_RET), f32),
        "w_ret_o": nrm(ks[9], (L, D_RET, D_MODEL), D_RET),
        "conv_w": nrm(ks[10], (L, CONV_K, D_CONV), CONV_K),
        "w_conv_o": nrm(ks[11], (L, D_CONV, D_MODEL), D_CONV),
        "w_out": nrm(ks[12], (L, D_MODEL, D_MODEL), D_MODEL),
        "norm2_w": 1.0 + 0.02 * jax.random.normal(ks[13], (L, D_MODEL), f32),
        "router_w": nrm(ks[14], (L, D_MODEL, N_EXPERTS), D_MODEL),
        "router_bias": 0.01 * jax.random.normal(ks[15], (L, N_EXPERTS), f32),
        "w_gate": nrm(ks[16], (L, N_EXPERTS, D_MODEL, D_EXPERT), D_MODEL),
        "w_up": nrm(ks[17], (L, N_EXPERTS, D_MODEL, D_EXPERT), D_MODEL),
        "w_down": nrm(ks[18], (L, N_EXPERTS, D_EXPERT, D_MODEL), D_EXPERT),
        "ws_gate": nrm(ks[19], (L, D_MODEL, D_SHARED), D_MODEL),
        "ws_up": nrm(ks[20], (L, D_MODEL, D_SHARED), D_MODEL),
        "ws_down": nrm(ks[21], (L, D_SHARED, D_MODEL), D_SHARED),
        "final_norm_w": 1.0 + 0.02 * jax.random.normal(ks[22], (D_MODEL,), f32),
    }


def reference(x, c, w_ada, b_ada, norm1_w, w_in, ret_decay_fwd, ret_decay_bwd, ret_norm_w,
              w_ret_o, conv_w, w_conv_o, w_out, norm2_w, router_w, router_bias, w_gate, w_up,
              w_down, ws_gate, ws_up, ws_down, final_norm_w):
    for l in range(DEPTH):
        mod = jax.nn.silu(c) @ w_ada[l] + b_ada[l]
        sh1, sc1, g1, sh2, sc2, g2 = jnp.split(mod[:, None, :], 6, axis=-1)
        h = rms_norm(x, norm1_w[l]) * (1.0 + sc1) + sh1
        x = x + g1 * token_mixer(h, w_in[l], ret_decay_fwd[l], ret_decay_bwd[l], ret_norm_w[l],
                                 w_ret_o[l], conv_w[l], w_conv_o[l], w_out[l])
        h = rms_norm(x, norm2_w[l]) * (1.0 + sc2) + sh2
        x = x + g2 * moe_ffn(h, router_w[l], router_bias[l], w_gate[l], w_up[l], w_down[l],
                             ws_gate[l], ws_up[l], ws_down[l])
    return rms_norm(x, final_norm_w)
```

```cpp
#include <hip/hip_runtime.h>
#include <cstdio>
#include <cstdint>

typedef unsigned short bf16;
typedef short bf16x8 __attribute__((ext_vector_type(8)));
typedef float f32x4 __attribute__((ext_vector_type(4)));
typedef unsigned u32x4 __attribute__((ext_vector_type(4)));
#define LAS __attribute__((address_space(3)))

constexpr int BATCH = 8, SEQ = 2048, T = BATCH * SEQ, D = 2048, DRET = 1024, NH = 8, HD = 128, CH = 128, NCH = 16;
constexpr int DCONV = 1024, DIN = 11264, NE = 64, TOPK = 8, DEXP = 512, DSH = 512;
constexpr float EPS = 1e-6f, ROUTED_SCALE = 2.5f;
constexpr int CAP = T * TOPK + NE * 256;
constexpr int NTHREADS = 512;

constexpr size_t MiB = 1u << 20;
constexpr size_t WS_CTL = 0, CTL_ZERO_BYTES = 1 * MiB;
constexpr size_t WS_MOD = 1 * MiB;
constexpr size_t WS_ROT = 2 * MiB;
constexpr size_t WS_SELE = 3 * MiB;
constexpr size_t WS_SELW = WS_SELE + 512 * 1024;
constexpr size_t WS_SELP = 4 * MiB;
constexpr size_t WS_PROW = WS_SELP + 512 * 1024;
constexpr size_t WS_RTOK = 5 * MiB;
constexpr size_t WS_RW = 6 * MiB;
constexpr size_t WS_WIN = 8 * MiB;
constexpr size_t WS_WRC = WS_WIN + 44 * MiB;
constexpr size_t WS_WOUT = WS_WRC + 8 * MiB;
constexpr size_t WS_WSGU = WS_WOUT + 8 * MiB;
constexpr size_t WS_WSD = WS_WSGU + 4 * MiB;
constexpr size_t WS_WD = 74 * MiB;
constexpr size_t WS_WGU = WS_WD + 128 * MiB;
constexpr size_t WS_ACTR = WS_WGU + 256 * MiB;
constexpr size_t WS_Q = WS_ACTR, WS_K = WS_Q + 32 * MiB, WS_V = WS_K + 32 * MiB, WS_G = WS_V + 32 * MiB, WS_CB = WS_G + 32 * MiB, WS_UP = WS_CB + 32 * MiB;
constexpr size_t WS_GR = WS_UP + 32 * MiB, WS_GC = WS_GR + 64 * MiB;
constexpr size_t WS_KVF = WS_GC + 64 * MiB, WS_KVB = WS_KVF + 32 * MiB;
constexpr size_t WS_ACAT = WS_KVB + 32 * MiB, WS_MERGED = WS_ACAT + 64 * MiB, WS_H = WS_MERGED + 64 * MiB;
constexpr size_t WS_END = WS_H + 64 * MiB;
constexpr size_t WS_Y = WS_WGU;
constexpr size_t WS_ACT = WS_ACTR + 320 * MiB;
constexpr size_t WS_ACTS = WS_ACT + 144 * MiB;
static_assert(WS_ACTS + 16 * MiB <= WS_H, "moe overlay");
static_assert((size_t)CAP * 2048 * 2 <= 576 * MiB && (size_t)CAP * 512 * 2 <= 144 * MiB, "cap");
constexpr int CW_CNT = 1024;
constexpr int CW_BASE = 1280;
constexpr int LDS_BYTES = 147456;

struct Params {
    const float *x, *c, *w_ada, *b_ada, *norm1_w, *w_in, *dec_f, *dec_b, *ret_norm_w, *w_ret_o, *conv_w, *w_conv_o, *w_out, *norm2_w,
        *router_w, *router_b, *w_gate, *w_up, *w_down, *ws_gate, *ws_up, *ws_down, *final_w;
    float* out; unsigned char* ws; int ph_lo, ph_hi;
};

__device__ __forceinline__ float bf2f(bf16 v) { return __uint_as_float((unsigned)v << 16); }
__device__ __forceinline__ bf16 f2bf(float f) { unsigned u = __float_as_uint(f); return (bf16)((u + 0x7fffu + ((u >> 16) & 1u)) >> 16); }
__device__ __forceinline__ float silu_f(float v) { return v / (1.f + __expf(-v)); }
__device__ __forceinline__ float sigmoid_f(float v) { return 1.f / (1.f + __expf(-v)); }
__device__ __forceinline__ float wave_sum(float v) {
#pragma unroll
    for (int o = 1; o < 64; o <<= 1) v += __shfl_xor(v, o);
    return v;
}
__device__ __forceinline__ float block_sum(float v, LAS float* red) {
    v = wave_sum(v);
    __syncthreads();
    if ((threadIdx.x & 63) == 0) red[threadIdx.x >> 6] = v;
    __syncthreads();
    float s = 0.f;
#pragma unroll
    for (int i = 0; i < NTHREADS / 64; ++i) s += red[i];
    return s;
}

__device__ __forceinline__ void ph_adaln(const Params& p, LAS unsigned char* lds, int bid, int nb) {
    LAS float* sc = (LAS float*)lds;
    LAS float* red = (LAS float*)(lds + 65536);
    for (int i = threadIdx.x; i < BATCH * D; i += NTHREADS) sc[i] = silu_f(p.c[i]);
    __syncthreads();
    float* mod = (float*)(p.ws + WS_MOD);
    const int c = threadIdx.x & 31, s = threadIdx.x >> 5;
    for (int item = bid; item < 6 * D / 32; item += nb) {
        const int col = item * 32 + c;
        float acc[8];
#pragma unroll
        for (int b = 0; b < 8; ++b) acc[b] = 0.f;
        for (int k = s * 128; k < s * 128 + 128; ++k) {
            const float w = p.w_ada[(size_t)k * (6 * D) + col];
#pragma unroll
            for (int b = 0; b < 8; ++b) acc[b] += sc[b * D + k] * w;
        }
#pragma unroll
        for (int b = 0; b < 8; ++b) red[(s * 8 + b) * 32 + c] = acc[b];
        __syncthreads();
        if (threadIdx.x < 256) {
            const int b = threadIdx.x >> 5; float t = 0.f;
#pragma unroll
            for (int ss = 0; ss < 16; ++ss) t += red[(ss * 8 + b) * 32 + c];
            mod[b * (6 * D) + col] = t + p.b_ada[col];
        }
        __syncthreads();
    }
    float2* rot = (float2*)(p.ws + WS_ROT);
    for (int i = bid * NTHREADS + threadIdx.x; i < SEQ * 64; i += nb * NTHREADS) {
        const int pos = i >> 6, f = i & 63;
        double inv = 1.0; const double rr = 0.86596432336006535;
        for (int t = 0; t < f; ++t) inv *= rr;
        const double ang = (double)pos * inv;
        const double q = __builtin_rint(ang * 0.63661977236758134308);
        const double r = __builtin_fma(-q, 1.57079632679489661923, ang), r2 = r * r;
        const double sn = r * (1.0 + r2 * (-1.0 / 6 + r2 * (1.0 / 120 + r2 * (-1.0 / 5040 + r2 * (1.0 / 362880 + r2 * (-1.0 / 39916800))))));
        const double cs = 1.0 + r2 * (-0.5 + r2 * (1.0 / 24 + r2 * (-1.0 / 720 + r2 * (1.0 / 40320 + r2 * (-1.0 / 3628800 + r2 * (1.0 / 479001600))))));
        const int qi = ((int)q) & 3;
        const double c2 = (qi == 0) ? cs : (qi == 1) ? -sn : (qi == 2) ? -cs : sn;
        const double s2 = (qi == 0) ? sn : (qi == 1) ? cs : (qi == 2) ? -sn : -cs;
        rot[i] = make_float2((float)c2, (float)s2);
    }
}

__device__ __forceinline__ void conv_tile(const float* src, const float* src2, int ld, bf16* dst, int dstLd, int koff, int kind, int n0, int k0, LAS float* tile) {
    const int tx = threadIdx.x & 31, ty = (threadIdx.x >> 5) & 15;
#pragma unroll
    for (int r = 0; r < 2; ++r) {
        const int k = k0 + ty + 16 * r, n = n0 + tx;
        const float* s = src; int col = n; float scale = 1.f;
        if (kind == 1) {
            if (n < 2048) { const int hb = n & ~127, j = n & 127; col = hb + (j >> 1) + 64 * (j & 1); if (n >= 1024) scale = 0.08838834764831845f; }
            else if (n >= 5120 && n < 7168) { const int l = n - 5120, grp = l >> 3, w = l & 7; col = (w < 4) ? 5120 + grp * 4 + w : 6144 + grp * 4 + (w - 4); }
        } else if (kind == 2) {
            const int grp = n >> 3, w = n & 7; col = grp * 4 + (w & 3); if (w >= 4) s = src2;
        }
        tile[(ty + 16 * r) * 33 + tx] = s[(size_t)k * ld + col] * scale;
    }
    __syncthreads();
#pragma unroll
    for (int r = 0; r < 2; ++r) {
        const int n = n0 + ty + 16 * r, k = k0 + tx;
        dst[(size_t)n * dstLd + koff + k] = f2bf(tile[tx * 33 + ty + 16 * r]);
    }
    __syncthreads();
}
__device__ __forceinline__ void conv_job(const float* src, const float* src2, int ld, int K, bf16* dst, int dstLd, int koff, int N, int kind, int nbatch, size_t srcStride, size_t dstStride,
                         LAS float* tile, int bid, int nb) {
    const int tn = N / 32, tk = K / 32, per = tn * tk;
    const long total = (long)per * nbatch;
    for (long it = bid; it < total; it += nb) {
        const int e = (int)(it / per), r = (int)(it % per), kt = r % tk, nt = r / tk;
        conv_tile(src + e * srcStride, src2 ? src2 + e * srcStride : nullptr, ld, dst + e * dstStride, dstLd, koff, kind, nt * 32, kt * 32, tile);
    }
}
__device__ __forceinline__ void ph_convert(const Params& p, LAS unsigned char* lds, int bid, int nb) {
    LAS float* tile = (LAS float*)lds;
    unsigned char* ws = p.ws;
    conv_job(p.w_in, nullptr, DIN, D, (bf16*)(ws + WS_WIN), D, 0, DIN, 1, 1, 0, 0, tile, bid, nb);
    conv_job(p.w_ret_o, nullptr, D, DRET, (bf16*)(ws + WS_WRC), 2048, 0, D, 0, 1, 0, 0, tile, bid, nb);
    conv_job(p.w_conv_o, nullptr, D, DCONV, (bf16*)(ws + WS_WRC), 2048, 1024, D, 0, 1, 0, 0, tile, bid, nb);
    conv_job(p.w_out, nullptr, D, D, (bf16*)(ws + WS_WOUT), D, 0, D, 0, 1, 0, 0, tile, bid, nb);
    conv_job(p.ws_gate, p.ws_up, DSH, D, (bf16*)(ws + WS_WSGU), D, 0, 2 * DSH, 2, 1, 0, 0, tile, bid, nb);
    conv_job(p.ws_down, nullptr, D, DSH, (bf16*)(ws + WS_WSD), DSH, 0, D, 0, 1, 0, 0, tile, bid, nb);
    conv_job(p.w_gate, p.w_up, DEXP, D, (bf16*)(ws + WS_WGU), D, 0, 2 * DEXP, 2, NE, (size_t)D * DEXP, (size_t)2 * DEXP * D, tile, bid, nb);
    conv_job(p.w_down, nullptr, D, DEXP, (bf16*)(ws + WS_WD), DEXP, 0, D, 0, NE, (size_t)DEXP * D, (size_t)D * DEXP, tile, bid, nb);
}

__device__ __forceinline__ void norm_row_load(const float* xrow, int lane, f32x4 (&v)[8], float& rstd) {
    const f32x4* xr = (const f32x4*)xrow + lane; float s = 0.f;
#pragma unroll
    for (int j = 0; j < 8; ++j) { v[j] = xr[64 * j]; s += (v[j].x * v[j].x + v[j].y * v[j].y) + (v[j].z * v[j].z + v[j].w * v[j].w); }
    rstd = rsqrtf(wave_sum(s) * (1.f / D) + EPS);
}
__device__ __forceinline__ void ph_norm1(const Params& p, int bid, int nb) {
    const int lane = threadIdx.x & 63, wave = threadIdx.x >> 6;
    const float* mod = (const float*)(p.ws + WS_MOD);
    bf16* H = (bf16*)(p.ws + WS_H);
    for (int row = bid * 8 + wave; row < T; row += nb * 8) {
        const int b = row / SEQ; f32x4 v[8]; float rstd;
        norm_row_load(p.x + (size_t)row * D, lane, v, rstd);
#pragma unroll
        for (int j = 0; j < 8; ++j) {
            const int col = 4 * lane + 256 * j;
            const f32x4 w = *(const f32x4*)(p.norm1_w + col), sh = *(const f32x4*)(mod + b * 6 * D + col), sc = *(const f32x4*)(mod + b * 6 * D + D + col);
            const f32x4 y = v[j] * rstd * w * (sc + 1.0f) + sh;
            unsigned long long o = (unsigned long long)f2bf(y.x) | ((unsigned long long)f2bf(y.y) << 16) | ((unsigned long long)f2bf(y.z) << 32) | ((unsigned long long)f2bf(y.w) << 48);
            *(unsigned long long*)(H + (size_t)row * D + col) = o;
        }
    }
}

struct GemmS { const bf16* A; int lda; const int* rowmap; const bf16* Bt; int ldb; int K; };
template <class Epi>
__device__ __forceinline__ void gemm_tile_simple(const GemmS& g, int brow, int bcol, LAS unsigned char* lds, const Epi& E) {
    LAS unsigned char* SA = lds; LAS unsigned char* SB = lds + 8192;
    const int tid = threadIdx.x, wid = tid >> 6, lane = tid & 63, wr = wid >> 2, wc = wid & 3, fr = lane & 15, fq = lane >> 4;
    const int ra = (tid * 16) / 64, ca = ((tid * 16) % 64) / 2;
    const int arow = g.rowmap ? g.rowmap[brow + ra] : brow + ra;
    const bf16* ga = g.A + (size_t)arow * g.lda + ca;
    const bf16* gb0 = g.Bt + (size_t)(bcol + ra) * g.ldb + ca;
    const bf16* gb1 = g.Bt + (size_t)(bcol + 128 + ra) * g.ldb + ca;
    f32x4 acc[4][4];
#pragma unroll
    for (int m = 0; m < 4; ++m)
#pragma unroll
        for (int n = 0; n < 4; ++n) acc[m][n] = (f32x4){0.f, 0.f, 0.f, 0.f};
    for (int kt = 0; kt < g.K; kt += 32) {
        __builtin_amdgcn_global_load_lds((const unsigned*)(ga + kt), (LAS unsigned*)(SA + tid * 16), 16, 0, 0);
        __builtin_amdgcn_global_load_lds((const unsigned*)(gb0 + kt), (LAS unsigned*)(SB + tid * 16), 16, 0, 0);
        __builtin_amdgcn_global_load_lds((const unsigned*)(gb1 + kt), (LAS unsigned*)(SB + 8192 + tid * 16), 16, 0, 0);
        asm volatile("s_waitcnt vmcnt(0)" ::: "memory"); __syncthreads();
        bf16x8 At[4], Bl[4];
#pragma unroll
        for (int m = 0; m < 4; ++m) At[m] = *(const LAS bf16x8*)(SA + (wr * 64 + m * 16 + fr) * 64 + fq * 16);
#pragma unroll
        for (int n = 0; n < 4; ++n) Bl[n] = *(const LAS bf16x8*)(SB + (wc * 64 + n * 16 + fr) * 64 + fq * 16);
#pragma unroll
        for (int m = 0; m < 4; ++m)
#pragma unroll
            for (int n = 0; n < 4; ++n) acc[m][n] = __builtin_amdgcn_mfma_f32_16x16x32_bf16(At[m], Bl[n], acc[m][n], 0, 0, 0);
        __syncthreads();
    }
#pragma unroll
    for (int m = 0; m < 4; ++m)
#pragma unroll
        for (int n = 0; n < 4; ++n)
#pragma unroll
            for (int j = 0; j < 4; ++j) E(brow + wr * 64 + m * 16 + fq * 4 + j, bcol + wc * 64 + n * 16 + fr, acc[m][n][j]);
}

struct EpiIn {
    bf16 *Q, *Kk, *V, *G, *CB, *UP, *GR, *GC; const float2* rot;
    __device__ __forceinline__ void operator()(int row, int col, float v) const {
        const float p1 = __shfl_xor(v, 1), p4 = __shfl_xor(v, 4);
        if (col < 2048) {
            const int f = (col & 127) >> 1, pos = row & (SEQ - 1);
            const float2 cs = rot[pos * 64 + f];
            const float o = (col & 1) ? (p1 * cs.y + v * cs.x) : (v * cs.x - p1 * cs.y);
            if (col < 1024) Q[(size_t)row * 1024 + col] = f2bf(o); else Kk[(size_t)row * 1024 + col - 1024] = f2bf(o);
        } else if (col < 3072) V[(size_t)row * 1024 + col - 2048] = f2bf(v);
        else if (col < 4096) G[(size_t)row * 1024 + col - 3072] = f2bf(silu_f(v));
        else if (col < 5120) CB[(size_t)row * 1024 + col - 4096] = f2bf(v);
        else if (col < 7168) { const int l = col - 5120; if ((l & 7) < 4) UP[(size_t)row * 1024 + (l >> 3) * 4 + (l & 3)] = f2bf(v * p4); }
        else if (col < 9216) GR[(size_t)row * 2048 + col - 7168] = f2bf(sigmoid_f(v));
        else GC[(size_t)row * 2048 + col - 9216] = f2bf(sigmoid_f(v));
    }
};
struct EpiMergeA { bf16* M; const bf16* GR; __device__ __forceinline__ void operator()(int row, int col, float v) const { const size_t i = (size_t)row * 2048 + col; M[i] = f2bf(bf2f(GR[i]) * v); } };
struct EpiMergeB { bf16* M; const bf16* GC; __device__ __forceinline__ void operator()(int row, int col, float v) const { const size_t i = (size_t)row * 2048 + col; M[i] = f2bf(bf2f(M[i]) + bf2f(GC[i]) * v); } };
struct EpiRes1 { const float* x; float* o; const float* mod; __device__ __forceinline__ void operator()(int row, int col, float v) const {
    const size_t i = (size_t)row * 2048 + col; const int b = row / SEQ; o[i] = x[i] + mod[b * 6 * D + 2 * D + col] * v; } };
struct EpiGU { bf16* ACT; __device__ __forceinline__ void operator()(int row, int col, float v) const {
    const float p4 = __shfl_xor(v, 4); if ((col & 7) < 4) ACT[(size_t)row * 512 + (col >> 3) * 4 + (col & 3)] = f2bf(silu_f(v) * p4); } };
struct EpiDown { bf16* Y; const float* rw; __device__ __forceinline__ void operator()(int row, int col, float v) const { Y[(size_t)row * 2048 + col] = f2bf(rw[row] * v); } };
struct EpiDownS { float* o; const float* mod; __device__ __forceinline__ void operator()(int row, int col, float v) const {
    const size_t i = (size_t)row * 2048 + col; const int b = row / SEQ; o[i] += mod[b * 6 * D + 5 * D + col] * v; } };

template <class Epi>
__device__ __forceinline__ void gemm_simple(const GemmS& g, int M, int N, LAS unsigned char* lds, const Epi& E, int bid, int nb) {
    const int tm = M / 128, tn = N / 256;
    for (int t = bid; t < tm * tn; t += nb) { const int pm = t / tn, pn = t % tn; gemm_tile_simple(g, pm * 128, pn * 256, lds, E); }
}

__device__ __forceinline__ float log_sigmoid_f(float x) { return -log1pf(expf(-x)); }
__device__ __forceinline__ void ph_kv_conv(const Params& p, LAS unsigned char* lds, int bid, int nb) {
    unsigned char* ws = p.ws;
    const bf16* Kk = (const bf16*)(ws + WS_K); const bf16* V = (const bf16*)(ws + WS_V);
    LAS float* kw = (LAS float*)lds;
    LAS float* vv = (LAS float*)(lds + 65536);
    for (int item = bid; item < BATCH * NH * NCH; item += nb) {
        const int n = item % NCH, h = (item / NCH) % NH, b = item / (NCH * NH);
        const float lgf = log_sigmoid_f(p.dec_f[h]), lgb = log_sigmoid_f(p.dec_b[h]);
        const size_t row0 = (size_t)b * SEQ + n * CH;
        for (int i = threadIdx.x; i < 128 * 128; i += NTHREADS) { const int j = i >> 7, d = i & 127;
            kw[i] = bf2f(Kk[(row0 + j) * 1024 + h * 128 + d]); vv[i] = bf2f(V[(row0 + j) * 1024 + h * 128 + d]); }
        __syncthreads();
        const int d = threadIdx.x >> 2, e0 = (threadIdx.x & 3) * 32;
        float af[32], ab[32];
#pragma unroll
        for (int e = 0; e < 32; ++e) { af[e] = 0.f; ab[e] = 0.f; }
        for (int j = 0; j < 128; ++j) {
            const float kd = kw[j * 128 + d], wf = __expf(lgf * (float)(127 - j)), wb = __expf(lgb * (float)j);
            const float kf = kd * wf, kb = kd * wb;
#pragma unroll
            for (int e = 0; e < 32; ++e) { const float ve = vv[j * 128 + e0 + e]; af[e] += kf * ve; ab[e] += kb * ve; }
        }
        bf16* of = (bf16*)(ws + WS_KVF) + ((size_t)item * 128 + d) * 128 + e0;
        bf16* ob = (bf16*)(ws + WS_KVB) + ((size_t)item * 128 + d) * 128 + e0;
#pragma unroll
        for (int e = 0; e < 32; ++e) { of[e] = f2bf(af[e]); ob[e] = f2bf(ab[e]); }
        __syncthreads();
    }
    const bf16* CB = (const bf16*)(ws + WS_CB); const bf16* UP = (const bf16*)(ws + WS_UP); bf16* ACAT = (bf16*)(ws + WS_ACAT);
    for (size_t i = (size_t)bid * NTHREADS + threadIdx.x; i < (size_t)T * DCONV; i += (size_t)nb * NTHREADS) {
        const int c = (int)(i & 1023); const size_t t = i >> 10; const int pos = (int)(t & (SEQ - 1));
        const float u0 = pos > 0 ? bf2f(UP[i - 1024]) : 0.f, u1 = bf2f(UP[i]), u2 = pos < SEQ - 1 ? bf2f(UP[i + 1024]) : 0.f;
        const float y = p.conv_w[c] * u0 + p.conv_w[1024 + c] * u1 + p.conv_w[2048 + c] * u2;
        ACAT[t * 2048 + 1024 + c] = f2bf(bf2f(CB[i]) * y);
    }
}

__device__ __forceinline__ void ph_ret_out(const Params& p, LAS unsigned char* lds, int bid, int nb) {
    unsigned char* ws = p.ws;
    const bf16* Q = (const bf16*)(ws + WS_Q); const bf16* Kk = (const bf16*)(ws + WS_K); const bf16* V = (const bf16*)(ws + WS_V); const bf16* G = (const bf16*)(ws + WS_G);
    const bf16* KVF = (const bf16*)(ws + WS_KVF); const bf16* KVB = (const bf16*)(ws + WS_KVB); bf16* ACAT = (bf16*)(ws + WS_ACAT);
    LAS float* S = (LAS float*)lds;
    LAS float* ST = (LAS float*)(lds + 65536);
    for (int item = bid; item < BATCH * NH * NCH; item += nb) {
        const int n = item % NCH, h = (item / NCH) % NH, b = item / (NCH * NH);
        const float lgf = log_sigmoid_f(p.dec_f[h]), lgb = log_sigmoid_f(p.dec_b[h]);
        const size_t row0 = (size_t)b * SEQ + n * CH;
        const int i = threadIdx.x >> 2, j0 = (threadIdx.x & 3) * 32;
        float sacc[32];
#pragma unroll
        for (int j = 0; j < 32; ++j) sacc[j] = 0.f;
        for (int d0 = 0; d0 < 128; d0 += 8) {
            float qv[8];
#pragma unroll
            for (int dd = 0; dd < 8; ++dd) qv[dd] = bf2f(Q[(row0 + i) * 1024 + h * 128 + d0 + dd]);
#pragma unroll
            for (int j = 0; j < 32; ++j) {
                const bf16* kr = Kk + (row0 + j0 + j) * 1024 + h * 128 + d0;
#pragma unroll
                for (int dd = 0; dd < 8; ++dd) sacc[j] += qv[dd] * bf2f(kr[dd]);
            }
        }
#pragma unroll
        for (int j = 0; j < 32; ++j) { const int jj = j0 + j; const float df = (float)(i - jj);
            const float m = (i >= jj) ? __expf(lgf * df) : __expf(-lgb * df); S[i * 128 + jj] = sacc[j] * m; }
        __syncthreads();
        const int e0 = (threadIdx.x & 3) * 32;
        float o[32];
#pragma unroll
        for (int e = 0; e < 32; ++e) o[e] = 0.f;
        for (int j = 0; j < 128; ++j) { const float s = S[i * 128 + j]; const bf16* vr = V + (row0 + j) * 1024 + h * 128 + e0;
#pragma unroll
            for (int e = 0; e < 32; ++e) o[e] += s * bf2f(vr[e]); }
        for (int dir = 0; dir < 2; ++dir) {
            __syncthreads();
            for (int idx = threadIdx.x; idx < 128 * 128; idx += NTHREADS) {
                float a = 0.f;
                if (dir == 0) { for (int m = 0; m < n; ++m) a += __expf(lgf * 128.f * (float)(n - 1 - m)) * bf2f(KVF[((size_t)(item - n + m) * 128 * 128) + idx]); }
                else { for (int m = n + 1; m < NCH; ++m) a += __expf(lgb * 128.f * (float)(m - n - 1)) * bf2f(KVB[((size_t)(item - n + m) * 128 * 128) + idx]); }
                ST[idx] = a;
            }
            __syncthreads();
            const float qs = (dir == 0) ? __expf(lgf * (float)(i + 1)) : __expf(lgb * (float)(128 - i));
            for (int d = 0; d < 128; ++d) { const float q = bf2f(Q[(row0 + i) * 1024 + h * 128 + d]) * qs;
#pragma unroll
                for (int e = 0; e < 32; ++e) o[e] += q * ST[d * 128 + e0 + e]; }
        }
        float ss = 0.f;
#pragma unroll
        for (int e = 0; e < 32; ++e) ss += o[e] * o[e];
        ss += __shfl_xor(ss, 1); ss += __shfl_xor(ss, 2);
        const float rstd = rsqrtf(ss * (1.f / 128.f) + EPS);
#pragma unroll
        for (int e = 0; e < 32; ++e) { const int col = h * 128 + e0 + e;
            ACAT[(row0 + i) * 2048 + col] = f2bf(bf2f(G[(row0 + i) * 1024 + col]) * (o[e] * rstd * p.ret_norm_w[col])); }
        __syncthreads();
    }
}

__device__ __forceinline__ void ph_norm2_route(const Params& p, LAS unsigned char* lds, int bid, int nb) {
    const int lane = threadIdx.x & 63, wave = threadIdx.x >> 6;
    unsigned char* ws = p.ws;
    const float* mod = (const float*)(ws + WS_MOD);
    bf16* H = (bf16*)(ws + WS_H);
    unsigned* ctl = (unsigned*)(ws + WS_CTL);
    int* selE = (int*)(ws + WS_SELE); float* selW = (float*)(ws + WS_SELW); int* selP = (int*)(ws + WS_SELP);
    LAS float* hrow = (LAS float*)lds + wave * 2048;
    for (int row = bid * 8 + wave; row < T; row += nb * 8) {
        const int b = row / SEQ; f32x4 v[8]; float rstd;
        norm_row_load(p.out + (size_t)row * D, lane, v, rstd);
#pragma unroll
        for (int j = 0; j < 8; ++j) {
            const int col = 4 * lane + 256 * j;
            const f32x4 w = *(const f32x4*)(p.norm2_w + col), sh = *(const f32x4*)(mod + b * 6 * D + 3 * D + col), sc = *(const f32x4*)(mod + b * 6 * D + 4 * D + col);
            const f32x4 y = v[j] * rstd * w * (sc + 1.0f) + sh;
            unsigned long long o = (unsigned long long)f2bf(y.x) | ((unsigned long long)f2bf(y.y) << 16) | ((unsigned long long)f2bf(y.z) << 32) | ((unsigned long long)f2bf(y.w) << 48);
            *(unsigned long long*)(H + (size_t)row * D + col) = o;
            *(LAS f32x4*)(hrow + col) = y;
        }
        asm volatile("s_waitcnt lgkmcnt(0)" ::: "memory");
        float lg = 0.f;
        for (int k = 0; k < D; ++k) lg += hrow[k] * p.router_w[(size_t)k * NE + lane];
        const float score = sigmoid_f(lg), biased = score + p.router_b[lane];
        float m1 = biased;
        m1 = fmaxf(m1, __shfl_xor(m1, 1)); m1 = fmaxf(m1, __shfl_xor(m1, 2)); m1 = fmaxf(m1, __shfl_xor(m1, 4));
        const unsigned long long eq = __ballot(biased == m1);
        const int gbase = lane & ~7;
        const unsigned geq = (unsigned)((eq >> gbase) & 0xffull);
        const int first = gbase + __builtin_ctz(geq);
        float m2 = (lane == first) ? -INFINITY : biased;
        m2 = fmaxf(m2, __shfl_xor(m2, 1)); m2 = fmaxf(m2, __shfl_xor(m2, 2)); m2 = fmaxf(m2, __shfl_xor(m2, 4));
        const float gs = m1 + m2;
        const int g = lane >> 3; int grank = 0;
#pragma unroll
        for (int gg = 0; gg < 8; ++gg) { const float o = __shfl(gs, gg * 8); grank += (o > gs || (o == gs && gg < g)) ? 1 : 0; }
        const float masked = (grank < 4) ? biased : -INFINITY;
        int rank = 0;
        for (int e = 0; e < 64; ++e) { const float o = __shfl(masked, e); rank += (o > masked || (o == masked && e < lane)) ? 1 : 0; }
        const bool sel = rank < TOPK;
        const float ssum = wave_sum(sel ? score : 0.f);
        if (sel) {
            const int pos = (int)atomicAdd(&ctl[CW_CNT + lane], 1u);
            selE[row * 8 + rank] = lane; selW[row * 8 + rank] = score / ssum * ROUTED_SCALE; selP[row * 8 + rank] = pos;
        }
    }
}
__device__ __forceinline__ void ph_offsets(const Params& p, LAS unsigned char* lds, int bid) {
    if (bid != 0) return;
    unsigned* ctl = (unsigned*)(p.ws + WS_CTL);
    int* rtok = (int*)(p.ws + WS_RTOK); float* rw = (float*)(p.ws + WS_RW);
    LAS int* sbase = (LAS int*)lds;
    if (threadIdx.x == 0) { int acc = 0; for (int e = 0; e < NE; ++e) { sbase[e] = acc; ctl[CW_BASE + e] = (unsigned)acc; acc += (int)((ctl[CW_CNT + e] + 255u) / 256u) * 256; } sbase[NE] = acc; ctl[CW_BASE + NE] = (unsigned)acc; }
    __syncthreads();
    for (int e = 0; e < NE; ++e) { const int lo = sbase[e] + (int)ctl[CW_CNT + e], hi = sbase[e + 1];
        for (int r = lo + threadIdx.x; r < hi; r += NTHREADS) { rtok[r] = 0; rw[r] = 0.f; } }
}
__device__ __forceinline__ void ph_scatter(const Params& p, int bid, int nb) {
    unsigned char* ws = p.ws; const unsigned* ctl = (const unsigned*)(ws + WS_CTL);
    const int* selE = (const int*)(ws + WS_SELE); const float* selW = (const float*)(ws + WS_SELW); const int* selP = (const int*)(ws + WS_SELP);
    int* prow = (int*)(ws + WS_PROW); int* rtok = (int*)(ws + WS_RTOK); float* rw = (float*)(ws + WS_RW);
    for (int i = bid * NTHREADS + threadIdx.x; i < T * TOPK; i += nb * NTHREADS) {
        const int e = selE[i], r = (int)ctl[CW_BASE + e] + selP[i];
        prow[i] = r; rtok[r] = i >> 3; rw[r] = selW[i];
    }
}
__device__ __forceinline__ int expert_of_row(const unsigned* ctl, int row) { int e = 0; while (e < NE - 1 && (int)ctl[CW_BASE + e + 1] <= row) ++e; return e; }
__device__ __forceinline__ void ph_moe_gu(const Params& p, LAS unsigned char* lds, int bid, int nb) {
    unsigned char* ws = p.ws; const unsigned* ctl = (const unsigned*)(ws + WS_CTL);
    const int rows = (int)ctl[CW_BASE + NE], tm = rows / 128, tn = 1024 / 256;
    EpiGU E{(bf16*)(ws + WS_ACT)};
    for (int t = bid; t < tm * tn; t += nb) { const int pm = t / tn, pn = t % tn; const int e = expert_of_row(ctl, pm * 128);
        GemmS g{(const bf16*)(ws + WS_H), D, (const int*)(ws + WS_RTOK), (const bf16*)(ws + WS_WGU) + (size_t)e * 1024 * D, D, D};
        gemm_tile_simple(g, pm * 128, pn * 256, lds, E); }
    GemmS gs{(const bf16*)(ws + WS_H), D, nullptr, (const bf16*)(ws + WS_WSGU), D, D};
    EpiGU Es{(bf16*)(ws + WS_ACTS)};
    gemm_simple(gs, T, 1024, lds, Es, bid, nb);
}
__device__ __forceinline__ void ph_moe_down(const Params& p, LAS unsigned char* lds, int bid, int nb) {
    unsigned char* ws = p.ws; const unsigned* ctl = (const unsigned*)(ws + WS_CTL);
    const int rows = (int)ctl[CW_BASE + NE], tm = rows / 128, tn = 2048 / 256;
    EpiDown E{(bf16*)(ws + WS_Y), (const float*)(ws + WS_RW)};
    for (int t = bid; t < tm * tn; t += nb) { const int pm = t / tn, pn = t % tn; const int e = expert_of_row(ctl, pm * 128);
        GemmS g{(const bf16*)(ws + WS_ACT), DEXP, nullptr, (const bf16*)(ws + WS_WD) + (size_t)e * D * DEXP, DEXP, DEXP};
        gemm_tile_simple(g, pm * 128, pn * 256, lds, E); }
    GemmS gs{(const bf16*)(ws + WS_ACTS), DSH, nullptr, (const bf16*)(ws + WS_WSD), DSH, DSH};
    EpiDownS Es{p.out, (const float*)(ws + WS_MOD)};
    gemm_simple(gs, T, 2048, lds, Es, bid, nb);
}
__device__ __forceinline__ void ph_combine(const Params& p, int bid, int nb) {
    const int lane = threadIdx.x & 63, wave = threadIdx.x >> 6;
    unsigned char* ws = p.ws; const float* mod = (const float*)(ws + WS_MOD); const bf16* Y = (const bf16*)(ws + WS_Y); const int* prow = (const int*)(ws + WS_PROW);
    for (int row = bid * 8 + wave; row < T; row += nb * 8) {
        const int b = row / SEQ; f32x4 v[8];
        int pr[8];
#pragma unroll
        for (int k = 0; k < 8; ++k) pr[k] = prow[row * 8 + k];
        float s = 0.f;
#pragma unroll
        for (int j = 0; j < 8; ++j) {
            const int col = 4 * lane + 256 * j;
            f32x4 a = (f32x4){0.f, 0.f, 0.f, 0.f};
#pragma unroll
            for (int k = 0; k < 8; ++k) { const unsigned long long y = *(const unsigned long long*)(Y + (size_t)pr[k] * 2048 + col);
                a.x += bf2f((bf16)(y & 0xffff)); a.y += bf2f((bf16)((y >> 16) & 0xffff)); a.z += bf2f((bf16)((y >> 32) & 0xffff)); a.w += bf2f((bf16)(y >> 48)); }
            const f32x4 g2 = *(const f32x4*)(mod + b * 6 * D + 5 * D + col);
            v[j] = *(const f32x4*)(p.out + (size_t)row * D + col) + g2 * a;
            s += (v[j].x * v[j].x + v[j].y * v[j].y) + (v[j].z * v[j].z + v[j].w * v[j].w);
        }
        const float rstd = rsqrtf(wave_sum(s) * (1.f / D) + EPS);
#pragma unroll
        for (int j = 0; j < 8; ++j) { const int col = 4 * lane + 256 * j; *(f32x4*)(p.out + (size_t)row * D + col) = v[j] * rstd * *(const f32x4*)(p.final_w + col); }
    }
}

constexpr int NPH = 15;
__global__ void __launch_bounds__(NTHREADS, 2) mk(Params p) {
    extern __shared__ __attribute__((aligned(16))) unsigned char lds_raw[];
    LAS unsigned char* lds = (LAS unsigned char*)lds_raw;
    const int bid = blockIdx.x, nb = gridDim.x;
    unsigned char* ws = p.ws;
#define IN(k) (p.ph_lo <= (k) && (k) < p.ph_hi)
    if (IN(0)) ph_adaln(p, lds, bid, nb);
    if (IN(1)) ph_convert(p, lds, bid, nb);
    if (IN(2)) ph_norm1(p, bid, nb);
    if (IN(3)) {
        GemmS g{(const bf16*)(ws + WS_H), D, nullptr, (const bf16*)(ws + WS_WIN), D, D};
        EpiIn E{(bf16*)(ws + WS_Q), (bf16*)(ws + WS_K), (bf16*)(ws + WS_V), (bf16*)(ws + WS_G), (bf16*)(ws + WS_CB), (bf16*)(ws + WS_UP), (bf16*)(ws + WS_GR), (bf16*)(ws + WS_GC), (const float2*)(ws + WS_ROT)};
        gemm_simple(g, T, DIN, lds, E, bid, nb);
    }
    if (IN(4)) ph_kv_conv(p, lds, bid, nb);
    if (IN(5)) ph_ret_out(p, lds, bid, nb);
    if (IN(6)) { GemmS g{(const bf16*)(ws + WS_ACAT), 2048, nullptr, (const bf16*)(ws + WS_WRC), 2048, 1024};
        EpiMergeA E{(bf16*)(ws + WS_MERGED), (const bf16*)(ws + WS_GR)}; gemm_simple(g, T, D, lds, E, bid, nb); }
    if (IN(7)) { GemmS g{(const bf16*)(ws + WS_ACAT) + 1024, 2048, nullptr, (const bf16*)(ws + WS_WRC) + 1024, 2048, 1024};
        EpiMergeB E{(bf16*)(ws + WS_MERGED), (const bf16*)(ws + WS_GC)}; gemm_simple(g, T, D, lds, E, bid, nb); }
    if (IN(8)) { GemmS g{(const bf16*)(ws + WS_MERGED), 2048, nullptr, (const bf16*)(ws + WS_WOUT), 2048, 2048};
        EpiRes1 E{p.x, p.out, (const float*)(ws + WS_MOD)}; gemm_simple(g, T, D, lds, E, bid, nb); }
    if (IN(9)) ph_norm2_route(p, lds, bid, nb);
    if (IN(10)) ph_offsets(p, lds, bid);
    if (IN(11)) ph_scatter(p, bid, nb);
    if (IN(12)) ph_moe_gu(p, lds, bid, nb);
    if (IN(13)) ph_moe_down(p, lds, bid, nb);
    if (IN(14)) ph_combine(p, bid, nb);
#undef IN
}

extern "C" void kernel_launch(void* const* d_in, const int* in_sizes, int n_in, void* d_out, int out_size, void* d_ws, size_t ws_size, hipStream_t stream) {
    static int grid = 0;
    if (grid == 0) {
        if (n_in != 23 || out_size != T * D || ws_size < WS_END) { fprintf(stderr, "kernel_launch: unexpected shapes (n_in %d out %d ws %zu need %zu)\n", n_in, out_size, ws_size, (size_t)WS_END); grid = -1; return; }
        if (hipFuncSetAttribute((const void*)mk, hipFuncAttributeMaxDynamicSharedMemorySize, LDS_BYTES) != hipSuccess) { fprintf(stderr, "hipFuncSetAttribute failed\n"); grid = -1; return; }
        int dev = 0, cus = 0; hipGetDevice(&dev); hipDeviceGetAttribute(&cus, hipDeviceAttributeMultiprocessorCount, dev);
        grid = cus > 0 ? cus : 256;
    }
    if (grid < 0) return;
    hipMemsetAsync((char*)d_ws + WS_CTL, 0, CTL_ZERO_BYTES, stream);
    Params p{};
    const float** pp = (const float**)&p;
    for (int i = 0; i < 23; ++i) pp[i] = (const float*)d_in[i];
    p.out = (float*)d_out; p.ws = (unsigned char*)d_ws;
    for (int ph = 0; ph < NPH; ++ph) {
        p.ph_lo = ph; p.ph_hi = ph + 1;
        hipLaunchKernelGGL(mk, dim3(grid), dim3(NTHREADS), LDS_BYTES, stream, p);
    }
}
```

```cpp
#include <hip/hip_runtime.h>
#include <cstdio>
#include <cstdint>

typedef unsigned short bf16;
typedef short bf16x8 __attribute__((ext_vector_type(8)));
typedef float f32x4 __attribute__((ext_vector_type(4)));
typedef unsigned u32x4 __attribute__((ext_vector_type(4)));
#define LAS __attribute__((address_space(3)))
#define GAS __attribute__((address_space(1)))

constexpr int BATCH = 8, SEQ = 2048, T = BATCH * SEQ, D = 2048, DRET = 1024, NH = 8, HD = 128, CH = 128, NCH = 16;
constexpr int DCONV = 1024, DIN = 11264, NE = 64, TOPK = 8, DEXP = 512, DSH = 512;
constexpr float EPS = 1e-6f, ROUTED_SCALE = 2.5f;
constexpr int CAP = T * TOPK + NE * 256;
constexpr int NTHREADS = 512;

constexpr size_t MiB = 1u << 20;
constexpr size_t WS_CTL = 0, CTL_ZERO_BYTES = 1 * MiB;
constexpr size_t WS_MOD = 1 * MiB;
constexpr size_t WS_ROT = 2 * MiB;
constexpr size_t WS_SELE = 3 * MiB;
constexpr size_t WS_SELW = WS_SELE + 512 * 1024;
constexpr size_t WS_SELP = 4 * MiB;
constexpr size_t WS_PROW = WS_SELP + 512 * 1024;
constexpr size_t WS_RTOK = 5 * MiB;
constexpr size_t WS_RWH = 5 * MiB, WS_RWL = WS_RWH + 256 * 1024;
constexpr size_t WS_RW = 6 * MiB;
constexpr size_t WS_WIN = 8 * MiB;
constexpr size_t WS_WRC = WS_WIN + 44 * MiB;
constexpr size_t WS_WOUT = WS_WRC + 8 * MiB;
constexpr size_t WS_WSGU = WS_WOUT + 8 * MiB;
constexpr size_t WS_WSD = WS_WSGU + 4 * MiB;
constexpr size_t WS_WD = 74 * MiB;
constexpr size_t WS_WGU = WS_WD + 128 * MiB;
constexpr size_t WS_ACTR = WS_WGU + 256 * MiB;
constexpr size_t WS_Q = WS_ACTR, WS_K = WS_Q + 32 * MiB, WS_V = WS_K + 32 * MiB, WS_G = WS_V + 32 * MiB, WS_CB = WS_G + 32 * MiB, WS_UP = WS_CB + 32 * MiB;
constexpr size_t WS_GR = WS_UP + 32 * MiB, WS_GC = WS_GR + 64 * MiB;
constexpr size_t WS_KVF = WS_GC + 64 * MiB, WS_KVB = WS_KVF + 32 * MiB;
constexpr size_t WS_ACAT = WS_KVB + 32 * MiB, WS_MERGED = WS_ACAT + 64 * MiB, WS_H = WS_MERGED + 64 * MiB;
constexpr size_t WS_H8A = WS_H + 64 * MiB;
constexpr size_t WS_WIN8 = WS_H8A + 32 * MiB;
constexpr size_t WS_LTOK = WS_WIN8 + 8 * MiB;
constexpr size_t WS_LW = WS_LTOK + 4 * MiB;
constexpr size_t WS_END = WS_LW + 4 * MiB;
constexpr size_t WS_Y = WS_WGU;
constexpr size_t WS_ACT = WS_ACTR + 320 * MiB;
constexpr size_t WS_ACTS = WS_ACT + 144 * MiB;
static_assert(WS_ACTS + 16 * MiB <= WS_H, "moe overlay");
static_assert((size_t)CAP * 2048 * 2 <= 576 * MiB && (size_t)CAP * 512 * 2 <= 144 * MiB, "cap");
constexpr int CW_CNT = 16384;
constexpr int CW_BASE = 1280;
constexpr int CW_Q = 2048;
constexpr int LDS_BYTES = 147456;

struct Params {
    const float *x, *c, *w_ada, *b_ada, *norm1_w, *w_in, *dec_f, *dec_b, *ret_norm_w, *w_ret_o, *conv_w, *w_conv_o, *w_out, *norm2_w,
        *router_w, *router_b, *w_gate, *w_up, *w_down, *ws_gate, *ws_up, *ws_down, *final_w;
    float* out; unsigned char* ws;
};

__device__ __forceinline__ float bf2f(bf16 v) { return __uint_as_float((unsigned)v << 16); }
__device__ __forceinline__ bf16 f2bf(float f) { unsigned u = __float_as_uint(f); return (bf16)((u + 0x7fffu + ((u >> 16) & 1u)) >> 16); }
__device__ __forceinline__ float sigmoid_f(float v) { return __builtin_amdgcn_rcpf(1.f + __builtin_amdgcn_exp2f(-1.4426950408889634f * v)); }
__device__ __forceinline__ float silu_f(float v) { return v * sigmoid_f(v); }
__device__ __forceinline__ unsigned pk4_fp8(float a, float b, float c, float d) {
    a = __builtin_amdgcn_fmed3f(a, -440.f, 440.f); b = __builtin_amdgcn_fmed3f(b, -440.f, 440.f); c = __builtin_amdgcn_fmed3f(c, -440.f, 440.f); d = __builtin_amdgcn_fmed3f(d, -440.f, 440.f);
    int p = 0; p = __builtin_amdgcn_cvt_pk_fp8_f32(a, b, p, false); p = __builtin_amdgcn_cvt_pk_fp8_f32(c, d, p, true); return (unsigned)p; }
__device__ __forceinline__ void lds_barrier() { asm volatile("s_waitcnt lgkmcnt(0)" ::: "memory"); __builtin_amdgcn_s_barrier(); asm volatile("" ::: "memory"); }
__device__ __forceinline__ float wave_sum(float v) {
#pragma unroll
    for (int o = 1; o < 64; o <<= 1) v += __shfl_xor(v, o);
    return v;
}
__device__ __forceinline__ float block_sum(float v, LAS float* red) {
    v = wave_sum(v);
    __syncthreads();
    if ((threadIdx.x & 63) == 0) red[threadIdx.x >> 6] = v;
    __syncthreads();
    float s = 0.f;
#pragma unroll
    for (int i = 0; i < NTHREADS / 64; ++i) s += red[i];
    return s;
}

__device__ __forceinline__ void ph_adaln(const Params& p, LAS unsigned char* lds, int bid, int nb) {
    LAS float* sc = (LAS float*)lds;
    LAS float* red = (LAS float*)(lds + 65536);
    for (int i = threadIdx.x; i < BATCH * D; i += NTHREADS) sc[i] = silu_f(p.c[i]);
    __syncthreads();
    float* mod = (float*)(p.ws + WS_MOD);
    const int c = threadIdx.x & 31, s = threadIdx.x >> 5;
    for (int item = bid; item < 6 * D / 32; item += nb) {
        const int col = item * 32 + c;
        float acc[8];
#pragma unroll
        for (int b = 0; b < 8; ++b) acc[b] = 0.f;
        for (int k0 = s * 128; k0 < s * 128 + 128; k0 += 32) {
            float w[32];
#pragma unroll
            for (int i = 0; i < 32; ++i) w[i] = __builtin_nontemporal_load(p.w_ada + (size_t)(k0 + i) * (6 * D) + col);
            asm volatile("" ::: "memory");
#pragma unroll
            for (int i = 0; i < 32; i += 8) asm volatile("" : "+v"(w[i]), "+v"(w[i + 1]), "+v"(w[i + 2]), "+v"(w[i + 3]), "+v"(w[i + 4]), "+v"(w[i + 5]), "+v"(w[i + 6]), "+v"(w[i + 7]));
#pragma unroll
            for (int i = 0; i < 32; i += 4)
#pragma unroll
                for (int b = 0; b < 8; ++b) { const f32x4 s4 = *(const LAS f32x4*)(sc + b * D + k0 + i); acc[b] += (s4.x * w[i] + s4.y * w[i + 1]) + (s4.z * w[i + 2] + s4.w * w[i + 3]); }
        }
#pragma unroll
        for (int b = 0; b < 8; ++b) red[(s * 8 + b) * 32 + c] = acc[b];
        __syncthreads();
        if (threadIdx.x < 256) {
            const int b = threadIdx.x >> 5; float t = 0.f;
#pragma unroll
            for (int ss = 0; ss < 16; ++ss) t += red[(ss * 8 + b) * 32 + c];
            mod[b * (6 * D) + col] = t + p.b_ada[col];
        }
        __syncthreads();
    }
    float2* rot = (float2*)(p.ws + WS_ROT);
    for (int i = bid * NTHREADS + threadIdx.x; i < SEQ * 64; i += nb * NTHREADS) {
        const int pos = i >> 6, f = i & 63;
        double inv = 1.0; const double rr = 0.86596432336006535;
        for (int t = 0; t < f; ++t) inv *= rr;
        const double ang = (double)pos * inv;
        const double q = __builtin_rint(ang * 0.63661977236758134308);
        const double r = __builtin_fma(-q, 1.57079632679489661923, ang), r2 = r * r;
        const double sn = r * (1.0 + r2 * (-1.0 / 6 + r2 * (1.0 / 120 + r2 * (-1.0 / 5040 + r2 * (1.0 / 362880 + r2 * (-1.0 / 39916800))))));
        const double cs = 1.0 + r2 * (-0.5 + r2 * (1.0 / 24 + r2 * (-1.0 / 720 + r2 * (1.0 / 40320 + r2 * (-1.0 / 3628800 + r2 * (1.0 / 479001600))))));
        const int qi = ((int)q) & 3;
        const double c2 = (qi == 0) ? cs : (qi == 1) ? -sn : (qi == 2) ? -cs : sn;
        const double s2 = (qi == 0) ? sn : (qi == 1) ? cs : (qi == 2) ? -sn : -cs;
        rot[i] = make_float2((float)c2, (float)s2);
    }
}

__device__ __forceinline__ int conv_dstrow(int kind, int c) {
    if (kind == 1) {
        if (c < 2048) { const int hb = c & ~127, j = c & 127; return hb + 2 * (j & 63) + (j >> 6); }
        if (c >= 5120 && c < 6144) { const int l = c - 5120; return 5120 + (l >> 7) * 256 + (l & 127); }
        if (c >= 6144 && c < 7168) { const int l = c - 6144; return 5120 + (l >> 7) * 256 + 128 + (l & 127); }
        return c;
    }
    if (kind == 2) return (c >> 7) * 256 + (c & 127);
    if (kind == 3) return (c >> 7) * 256 + 128 + (c & 127);
    return c;
}
__device__ __forceinline__ void conv_item(const float* src, int ld, bf16* dst, int dstLd, int koff, int kind, int n0, int k0, LAS unsigned char* img, int lane) {
    const int ng = lane >> 2, kg = lane & 3;
    const float scale = (kind == 1 && n0 >= 1024 && n0 < 2048) ? 0.08838834764831845f : 1.0f;
#pragma unroll
    for (int g = 0; g < 4; ++g) {
        f32x4 v[4];
#pragma unroll
        for (int i = 0; i < 4; ++i) v[i] = __builtin_nontemporal_load((const f32x4*)(src + (size_t)(k0 + 16 * g + 4 * kg + i) * ld + n0 + 4 * ng));
#pragma unroll
        for (int j = 0; j < 4; ++j) {
            const unsigned lo = (unsigned)f2bf(v[0][j] * scale) | ((unsigned)f2bf(v[1][j] * scale) << 16), hi = (unsigned)f2bf(v[2][j] * scale) | ((unsigned)f2bf(v[3][j] * scale) << 16);
            *(LAS unsigned long long*)(img + (4 * ng + j) * 144 + (16 * g + 4 * kg) * 2) = (unsigned long long)lo | ((unsigned long long)hi << 32);
        }
    }
    asm volatile("s_waitcnt lgkmcnt(0)" ::: "memory");
#pragma unroll
    for (int r = 0; r < 8; ++r) {
        const int n = 8 * r + (lane >> 3), kc = lane & 7;
        const u32x4 w = *(const LAS u32x4*)(img + n * 144 + kc * 16);
        *(u32x4*)(dst + (size_t)conv_dstrow(kind, n0 + n) * dstLd + koff + k0 + kc * 8) = w;
    }
    asm volatile("s_waitcnt lgkmcnt(0)" ::: "memory");
}
__device__ __forceinline__ void conv_item8(const float* src, int ld, unsigned char* dst, int dstLd, int kind, int n0, int k0, float scale, LAS unsigned char* img, int lane) {
    const int ng = lane >> 2, kg = lane & 3;
#pragma unroll
    for (int g = 0; g < 4; ++g) {
        f32x4 v[4];
#pragma unroll
        for (int i = 0; i < 4; ++i) v[i] = __builtin_nontemporal_load((const f32x4*)(src + (size_t)(k0 + 16 * g + 4 * kg + i) * ld + n0 + 4 * ng));
#pragma unroll
        for (int j = 0; j < 4; ++j) *(LAS unsigned*)(img + (4 * ng + j) * 80 + 16 * g + 4 * kg) = pk4_fp8(v[0][j] * scale, v[1][j] * scale, v[2][j] * scale, v[3][j] * scale);
    }
    asm volatile("s_waitcnt lgkmcnt(0)" ::: "memory");
#pragma unroll
    for (int r = 0; r < 4; ++r) {
        const int n = 16 * r + (lane >> 2), kc = lane & 3;
        const u32x4 w = *(const LAS u32x4*)(img + n * 80 + kc * 16);
        *(u32x4*)(dst + (size_t)conv_dstrow(kind, n0 + n) * dstLd + k0 + kc * 16) = w;
    }
    asm volatile("s_waitcnt lgkmcnt(0)" ::: "memory");
}
constexpr int CJ_WORDS = 16, CJ_LDS = 8 * 9216;
__device__ __forceinline__ void conv_job_add(LAS unsigned* tab, int& nj, int& nbat, const float* src, int ld, int K, void* dst, int dstLd, int koff, int N, int kind, int fp8, float scale, int nbatch, unsigned srcStride, unsigned dstStride) {
    LAS unsigned* t = tab + nj * CJ_WORDS; const int tn = N / 64, per = tn * (K / 64);
    t[0] = (unsigned)(size_t)src; t[1] = (unsigned)((size_t)src >> 32); t[2] = (unsigned)(size_t)dst; t[3] = (unsigned)((size_t)dst >> 32);
    t[4] = ld; t[5] = dstLd; t[6] = koff; t[7] = tn; t[8] = per; t[9] = kind; t[10] = fp8; t[11] = __float_as_uint(scale); t[12] = srcStride; t[13] = dstStride; t[14] = nbat;
    nbat += per * nbatch / 16; ++nj;
}
__device__ __forceinline__ void ph_convert(const Params& p, LAS unsigned char* lds, volatile LAS unsigned* shw) {
    int tidl = threadIdx.x; asm volatile("" : "+v"(tidl));
    const int lane = tidl & 63, wave = tidl >> 6;
    LAS unsigned char* img = lds + wave * 9216;
    LAS unsigned* tab = (LAS unsigned*)(lds + CJ_LDS);
    unsigned char* ws = p.ws;
    constexpr float SC_GU = 64.f, SC_DN = 32.f;
    if (threadIdx.x == 0) {
        int nj = 0, nbat = 0;
        conv_job_add(tab, nj, nbat, p.w_in, DIN, D, ws + WS_WIN, D, 0, 7168, 1, 0, 1.f, 1, 0, 0);
        conv_job_add(tab, nj, nbat, p.w_in + 7168, DIN, D, ws + WS_WIN8, D, 0, 4096, 0, 1, 64.f, 1, 0, 0);
        conv_job_add(tab, nj, nbat, p.w_ret_o, D, DRET, ws + WS_WRC, 2048, 0, D, 0, 0, 1.f, 1, 0, 0);
        conv_job_add(tab, nj, nbat, p.w_conv_o, D, DCONV, ws + WS_WRC, 2048, 1024, D, 0, 0, 1.f, 1, 0, 0);
        conv_job_add(tab, nj, nbat, p.w_out, D, D, ws + WS_WOUT, D, 0, D, 0, 0, 1.f, 1, 0, 0);
        conv_job_add(tab, nj, nbat, p.ws_gate, DSH, D, ws + WS_WSGU, D, 0, DSH, 2, 1, SC_GU, 1, 0, 0);
        conv_job_add(tab, nj, nbat, p.ws_up, DSH, D, ws + WS_WSGU, D, 0, DSH, 3, 1, SC_GU, 1, 0, 0);
        conv_job_add(tab, nj, nbat, p.ws_down, D, DSH, ws + WS_WSD, DSH, 0, D, 0, 1, SC_DN, 1, 0, 0);
        conv_job_add(tab, nj, nbat, p.w_gate, DEXP, D, ws + WS_WGU, D, 0, DEXP, 2, 1, SC_GU, NE, D * DEXP, 2 * DEXP * D);
        conv_job_add(tab, nj, nbat, p.w_up, DEXP, D, ws + WS_WGU, D, 0, DEXP, 3, 1, SC_GU, NE, D * DEXP, 2 * DEXP * D);
        tab[nj * CJ_WORDS + 14] = nbat; tab[255] = nj;
    }
    __syncthreads();
    const int nj = (int)tab[255], total = (int)tab[nj * CJ_WORDS + 14];
    unsigned* q = (unsigned*)(ws + WS_CTL) + CW_Q + 64;
    unsigned cur = 0;
    if (threadIdx.x == 0) cur = atomicAdd(q, 1u);
    for (;;) {
        if (threadIdx.x == 0) *shw = cur;
        lds_barrier();
        const int b = __builtin_amdgcn_readfirstlane((int)*shw);
        if (b >= total) break;
        if (threadIdx.x == 0) cur = atomicAdd(q, 1u);
        int j = 0;
        while (j + 1 < nj && b >= (int)tab[(j + 1) * CJ_WORDS + 14]) ++j;
        const LAS unsigned* t = tab + j * CJ_WORDS;
#define CJ(i) ((unsigned)__builtin_amdgcn_readfirstlane((int)t[i]))
        const float* src = (const float*)(const float GAS*)(((size_t)CJ(1) << 32) | CJ(0)); unsigned char* dst = (unsigned char*)(unsigned char GAS*)(((size_t)CJ(3) << 32) | CJ(2));
        const int ld = (int)CJ(4), dstLd = (int)CJ(5), koff = (int)CJ(6), tn = (int)CJ(7), per = (int)CJ(8), kind = (int)CJ(9), fp8 = (int)CJ(10); const float scale = __uint_as_float(CJ(11));
        const size_t sstr = CJ(12), dstr = CJ(13); const int b0 = (int)CJ(14);
#undef CJ
#pragma unroll 1
        for (int jj = 0; jj < 2; ++jj) {
            const int it = (b - b0) * 16 + wave * 2 + jj, e = it / per, r = it % per, nt = r % tn, kt = r / tn;
            if (fp8) conv_item8(src + e * sstr, ld, dst + e * dstr, dstLd, kind, nt * 64, kt * 64, scale, img, lane);
            else conv_item(src + e * sstr, ld, (bf16*)dst + e * dstr, dstLd, koff, kind, nt * 64, kt * 64, img, lane);
        }
        lds_barrier();
    }
    lds_barrier();
}
__device__ __forceinline__ void conv_down_queue(const Params& p, LAS unsigned char* lds, volatile LAS unsigned* shw) {
    int tidl = threadIdx.x; asm volatile("" : "+v"(tidl));
    const int lane = tidl & 63, wave = tidl >> 6;
    LAS unsigned char* img = lds + wave * 9216;
    unsigned char* wsq = p.ws; asm volatile("" : "+s"(wsq));
    unsigned* q = (unsigned*)(wsq + WS_CTL) + CW_Q;
    constexpr int TN = D / 64, PER = TN * (DEXP / 64), NBATCH = PER * NE / 16;
    unsigned cur = 0;
    if (threadIdx.x == 0) cur = atomicAdd(q, 1u);
    for (;;) {
        if (threadIdx.x == 0) *shw = cur;
        lds_barrier();
        const unsigned b = *shw;
        if (b >= (unsigned)NBATCH) break;
        if (threadIdx.x == 0) cur = atomicAdd(q, 1u);
#pragma unroll 1
        for (int j = 0; j < 2; ++j) {
            const int it = (int)b * 16 + wave * 2 + j, e = it / PER, r = it % PER, nt = r % TN, kt = r / TN;
            conv_item8(p.w_down + (size_t)e * DEXP * D, D, p.ws + WS_WD + (size_t)e * D * DEXP, DEXP, 0, nt * 64, kt * 64, 32.f, img, lane);
        }
        lds_barrier();
    }
}

__device__ __forceinline__ void norm_row_load(const float* xrow, int lane, f32x4 (&v)[8], float& rstd) {
    const f32x4* xr = (const f32x4*)xrow + lane; float s = 0.f;
#pragma unroll
    for (int j = 0; j < 8; ++j) { v[j] = xr[64 * j]; s += (v[j].x * v[j].x + v[j].y * v[j].y) + (v[j].z * v[j].z + v[j].w * v[j].w); }
    rstd = rsqrtf(wave_sum(s) * (1.f / D) + EPS);
}
__device__ __forceinline__ void ph_norm1(const Params& p, int bid, int nb) {
    int tidl = threadIdx.x; asm volatile("" : "+v"(tidl));
    const int lane = tidl & 63, wave = tidl >> 6;
    const float* mod = (const float*)(p.ws + WS_MOD);
    bf16* H = (bf16*)(p.ws + WS_H);
    for (int idx = bid * NTHREADS + threadIdx.x; idx < D * NE; idx += nb * NTHREADS) {
        const int k = idx >> 6, e = idx & 63; const float v = p.router_w[idx]; const bf16 hi = f2bf(v);
        const int pos = (((((k >> 8) * 8 + ((k >> 5) & 7)) * 4 + (e & 3)) * 64 + ((k >> 3) & 3) * 16 + (e >> 2)) << 3) + (k & 7);
        ((bf16*)(p.ws + WS_RWH))[pos] = hi; ((bf16*)(p.ws + WS_RWL))[pos] = f2bf(v - bf2f(hi)); }
    f32x4 w[8];
#pragma unroll
    for (int j = 0; j < 8; ++j) w[j] = *(const f32x4*)(p.norm1_w + 4 * lane + 256 * j);
    for (int row = bid * 8 + wave; row < T; row += nb * 8) {
        const int b = row / SEQ; f32x4 v[8], sh[8], sc[8];
#pragma unroll
        for (int j = 0; j < 8; ++j) { v[j] = ((const f32x4*)(p.x + (size_t)row * D) + lane)[64 * j]; sh[j] = *(const f32x4*)(mod + b * 6 * D + 4 * lane + 256 * j); sc[j] = *(const f32x4*)(mod + b * 6 * D + D + 4 * lane + 256 * j); }
        asm volatile("" ::: "memory");
        asm volatile("" : "+v"(v[0]), "+v"(v[1]), "+v"(v[2]), "+v"(v[3]), "+v"(v[4]), "+v"(v[5]), "+v"(v[6]), "+v"(v[7]));
        asm volatile("" : "+v"(sh[0]), "+v"(sh[1]), "+v"(sh[2]), "+v"(sh[3]), "+v"(sh[4]), "+v"(sh[5]), "+v"(sh[6]), "+v"(sh[7]));
        asm volatile("" : "+v"(sc[0]), "+v"(sc[1]), "+v"(sc[2]), "+v"(sc[3]), "+v"(sc[4]), "+v"(sc[5]), "+v"(sc[6]), "+v"(sc[7]));
        float ss = 0.f;
#pragma unroll
        for (int j = 0; j < 8; ++j) ss += (v[j].x * v[j].x + v[j].y * v[j].y) + (v[j].z * v[j].z + v[j].w * v[j].w);
        const float rstd = rsqrtf(wave_sum(ss) * (1.f / D) + EPS);
#pragma unroll
        for (int j = 0; j < 8; ++j) {
            const int col = 4 * lane + 256 * j;
            const f32x4 y = v[j] * rstd * w[j] * (sc[j] + 1.0f) + sh[j];
            unsigned long long o = (unsigned long long)f2bf(y.x) | ((unsigned long long)f2bf(y.y) << 16) | ((unsigned long long)f2bf(y.z) << 32) | ((unsigned long long)f2bf(y.w) << 48);
            *(unsigned long long*)(H + (size_t)row * D + col) = o;
            *(unsigned*)(p.ws + WS_H8A + (size_t)row * D + col) = pk4_fp8(y.x, y.y, y.z, y.w);
        }
    }
}

struct GemmS { const bf16* A; int lda; const int* rowmap; const bf16* Bt; int ldb; int K; };
template <class Epi>
__device__ __forceinline__ void gemm_tile_simple(const GemmS& g, int brow, int bcol, LAS unsigned char* lds, const Epi& E) {
    LAS unsigned char* SA = lds; LAS unsigned char* SB = lds + 8192;
    const int tid = threadIdx.x, wid = tid >> 6, lane = tid & 63, wr = wid >> 2, wc = wid & 3, fr = lane & 15, fq = lane >> 4;
    const int ra = (tid * 16) / 64, ca = ((tid * 16) % 64) / 2;
    const int arow = g.rowmap ? g.rowmap[brow + ra] : brow + ra;
    const bf16* ga = g.A + (size_t)arow * g.lda + ca;
    const bf16* gb0 = g.Bt + (size_t)(bcol + ra) * g.ldb + ca;
    const bf16* gb1 = g.Bt + (size_t)(bcol + 128 + ra) * g.ldb + ca;
    f32x4 acc[4][4];
#pragma unroll
    for (int m = 0; m < 4; ++m)
#pragma unroll
        for (int n = 0; n < 4; ++n) acc[m][n] = (f32x4){0.f, 0.f, 0.f, 0.f};
    for (int kt = 0; kt < g.K; kt += 32) {
        __builtin_amdgcn_global_load_lds((const unsigned*)(ga + kt), (LAS unsigned*)(SA + tid * 16), 16, 0, 0);
        __builtin_amdgcn_global_load_lds((const unsigned*)(gb0 + kt), (LAS unsigned*)(SB + tid * 16), 16, 0, 0);
        __builtin_amdgcn_global_load_lds((const unsigned*)(gb1 + kt), (LAS unsigned*)(SB + 8192 + tid * 16), 16, 0, 0);
        asm volatile("s_waitcnt vmcnt(0)" ::: "memory"); __syncthreads();
        bf16x8 At[4], Bl[4];
#pragma unroll
        for (int m = 0; m < 4; ++m) At[m] = *(const LAS bf16x8*)(SA + (wr * 64 + m * 16 + fr) * 64 + fq * 16);
#pragma unroll
        for (int n = 0; n < 4; ++n) Bl[n] = *(const LAS bf16x8*)(SB + (wc * 64 + n * 16 + fr) * 64 + fq * 16);
#pragma unroll
        for (int m = 0; m < 4; ++m)
#pragma unroll
            for (int n = 0; n < 4; ++n) acc[m][n] = __builtin_amdgcn_mfma_f32_16x16x32_bf16(At[m], Bl[n], acc[m][n], 0, 0, 0);
        __syncthreads();
    }
#pragma unroll
    for (int m = 0; m < 4; ++m)
#pragma unroll
        for (int n = 0; n < 4; ++n)
#pragma unroll
            for (int j = 0; j < 4; ++j) E(brow + wr * 64 + m * 16 + fq * 4 + j, bcol + wc * 64 + n * 16 + fr, acc[m][n][j]);
}


namespace pg8 {
constexpr int BM = 256, BK = 64, HALF = 128, HTB = HALF * BK * 2, STAGE_BYTES = 8 * HTB, NXCD = 8, WGM = 8;
__host__ __device__ __forceinline__ int lds_byte(int r, int c) { const int st = (r >> 4) * 2 + (c >> 5), rr = r & 15, cc = c & 31, ob = rr * 64 + cc * 2; return st * 1024 + (ob ^ (((ob >> 9) & 1) << 5)); }
__host__ __device__ __forceinline__ void stage_rc(int b, int& R, int& C) { const int st = b / 1024, sb = b % 1024, swz = sb ^ (((sb >> 9) & 1) << 5); R = (st >> 1) * 16 + swz / 64; C = (st & 1) * 32 + (swz % 64) / 2; }
__host__ __device__ __forceinline__ int perm32(int rho) { const int n = rho >> 4, i = rho & 15; return 8 * (i >> 2) + 4 * n + (i & 3); }
typedef float f32x2n __attribute__((ext_vector_type(2)));
typedef __bf16 bf16x2n __attribute__((ext_vector_type(2)));
__device__ __forceinline__ unsigned cvt_pk_bf16(float lo, float hi) { const f32x2n v = {lo, hi}; return __builtin_bit_cast(unsigned, __builtin_convertvector(v, bf16x2n)); }
__device__ __forceinline__ u32x4 pack8(const f32x4& a, const f32x4& b) { u32x4 w; w.x = cvt_pk_bf16(a[0], a[1]); w.y = cvt_pk_bf16(a[2], a[3]); w.z = cvt_pk_bf16(b[0], b[1]); w.w = cvt_pk_bf16(b[2], b[3]); return w; }
__device__ __forceinline__ void unpack8(const u32x4& w, f32x4& a, f32x4& b) {
    a[0] = __uint_as_float(w.x << 16); a[1] = __uint_as_float(w.x & 0xffff0000u); a[2] = __uint_as_float(w.y << 16); a[3] = __uint_as_float(w.y & 0xffff0000u);
    b[0] = __uint_as_float(w.z << 16); b[1] = __uint_as_float(w.z & 0xffff0000u); b[2] = __uint_as_float(w.w << 16); b[3] = __uint_as_float(w.w & 0xffff0000u); }

struct Unit { int pm, pn; int orow0; int e; int kind; const char* Bp; };
__device__ __forceinline__ bool static_tile(int i, int G, int c, int nM, int nN, int& pm, int& pn) {
    const int nwg = nM * nN; const long L = (long)i * G + c; if (L >= nwg) return false;
    int wgid = (int)L; { const int q = nwg / NXCD, r = nwg % NXCD, xcd = wgid % NXCD, off = wgid / NXCD; wgid = (xcd < r ? xcd * (q + 1) : r * (q + 1) + (xcd - r) * q) + off; }
    const int nig = WGM * nN, gid = wgid / nig, fm = gid * WGM, gsz = (nM - fm) < WGM ? (nM - fm) : WGM;
    pm = fm + ((wgid % nig) % gsz); pn = (wgid % nig) / gsz; return true;
}
struct DenseSched {
    const bf16* A; int lda; const bf16* Bt; int ldb; int K; int nM, nN, G, c; int i0 = 0, i1 = 1 << 30;
    __device__ __forceinline__ bool next(int i, Unit& u) const { int pm, pn; i += i0; if (i >= i1) return false; if (!static_tile(i, G, c, nM, nN, pm, pn)) return false;
        u.pm = pm; u.pn = pn; u.orow0 = pm * BM; u.e = 0; u.kind = 0; u.Bp = (const char*)Bt + (size_t)pn * BM * ldb; return true; }
    static constexpr bool GATHER_A = false, FP8 = false; static constexpr int sA = 127, sB = 127;
    __device__ __forceinline__ void a_offsets(const Unit&, int, unsigned (&)[2][2]) const {}
};

typedef int i32x4v __attribute__((ext_vector_type(4)));
typedef int i32x8v __attribute__((ext_vector_type(8)));
__device__ __forceinline__ i32x8v cat8(bf16x8 lo, bf16x8 hi) { return __builtin_shufflevector(__builtin_bit_cast(i32x4v, lo), __builtin_bit_cast(i32x4v, hi), 0, 1, 2, 3, 4, 5, 6, 7); }
template <int SA_, int SB_> struct DenseSched8 : DenseSched { static constexpr bool FP8 = true; static constexpr int sA = SA_, sB = SB_; };
template <class Epi, class Sched, bool ALIGN_EPI, bool HAS_MID, bool RELAX = false>
__device__ __forceinline__ void gemm_phase(LAS unsigned char* lds, const Sched& S, const Epi& E, int midt) {
    constexpr bool GA = Sched::GATHER_A;
    int tid = threadIdx.x; asm volatile("" : "+v"(tid));
    const int wid = __builtin_amdgcn_readfirstlane(tid >> 6), lane = tid & 63, wr = wid >> 2, wc = wid & 3, fr = lane & 15, fq = lane >> 4;
    const int K = S.K, nt = K / (BK * 2), ldb = S.ldb, lda = S.lda;
    unsigned voffB[2], voffA[2];
#pragma unroll
    for (int i = 0; i < 2; ++i) { int R, C; stage_rc(tid * 16 + i * 8192, R, C); int Rb = Epi::PERM ? ((R & ~31) + perm32(R & 31)) : R;
        if constexpr (Epi::PERM16) Rb = (R >> 5) * 64 + ((R >> 2) & 3) * 16 + ((R >> 4) & 1) * 4 + (R & 3);
        voffB[i] = (unsigned)(Rb * ldb + C * 2); voffA[i] = (unsigned)(R * lda + C * 2); }
    const size_t kstep = (size_t)(BK * 2);
    const size_t hstepB = (size_t)(Epi::PERM16 ? 8 : HALF) * ldb, hstepA = (size_t)HALF * lda;
    const unsigned ldsw = (unsigned)wid * 1024u;
    const int aoff = lds_byte(wr * 64 + fr, fq * 8), boff = lds_byte(wc * 32 + fr, fq * 8);
    const char* Abase = (const char*)S.A;
#define PG8_SA(b, h) (((b) * 2 + (h)) * HTB)
#define PG8_SB(b, h) ((4 + (b) * 2 + (h)) * HTB)
#define PG8_STAGE(bufoff, gbase, voff) do { _Pragma("unroll") for (int _i = 0; _i < 2; ++_i) \
        __builtin_amdgcn_global_load_lds((const unsigned*)((const char*)(gbase) + (voff)[_i]), (LAS unsigned*)(lds + (bufoff) + ldsw + _i * 8192), 16, 0, 0); } while (0)
#define PG8_STAGE_AC(bufoff, h, kb) do { if constexpr (GA) { PG8_STAGE(bufoff, Abase + (kb), vc[h]); } else { PG8_STAGE(bufoff, cA + (h) * hstepA + (kb), voffA); } } while (0)
#define PG8_STAGE_AN(bufoff, h, kb) do { if constexpr (GA) { PG8_STAGE(bufoff, ag2 + (kb), v2[h]); } \
        else { PG8_STAGE(bufoff, a2 + (h) * hstepA + (kb), voffA); } } while (0)
#define PG8_LDA(dst, b, h) do { _Pragma("unroll") for (int m = 0; m < 4; ++m) { if constexpr (Sched::FP8) dst##8[m] = cat8(*(const LAS bf16x8*)(lds + PG8_SA(b, h) + aoff + m * 2048), *(const LAS bf16x8*)(lds + PG8_SA(b, h) + aoff + m * 2048 + 1024)); \
        else { _Pragma("unroll") for (int k = 0; k < 2; ++k) dst[m][k] = *(const LAS bf16x8*)(lds + PG8_SA(b, h) + aoff + m * 2048 + k * 1024); } } } while (0)
#define PG8_LDB(dst, b, h) do { _Pragma("unroll") for (int n = 0; n < 2; ++n) { if constexpr (Sched::FP8) dst##8[n] = cat8(*(const LAS bf16x8*)(lds + PG8_SB(b, h) + boff + n * 2048), *(const LAS bf16x8*)(lds + PG8_SB(b, h) + boff + n * 2048 + 1024)); \
        else { _Pragma("unroll") for (int k = 0; k < 2; ++k) dst[n][k] = *(const LAS bf16x8*)(lds + PG8_SB(b, h) + boff + n * 2048 + k * 1024); } } } while (0)
#define PG8_MMA(ai, bj, At, Bt) do { __builtin_amdgcn_s_setprio(1); _Pragma("unroll") for (int m = 0; m < 4; ++m) _Pragma("unroll") for (int n = 0; n < 2; ++n) { \
        if constexpr (Sched::FP8) asm volatile("v_mfma_scale_f32_16x16x128_f8f6f4 %0, %1, %2, %0, %3, %4 op_sel_hi:[0,0,0]" : "+v"(acc[ai][bj][m][n]) : "v"(Bt##8[n]), "v"(At##8[m]), "v"(scB), "v"(scA)); \
        else { _Pragma("unroll") for (int k = 0; k < 2; ++k) acc[ai][bj][m][n] = __builtin_amdgcn_mfma_f32_16x16x32_bf16(Bt[n][k], At[m][k], acc[ai][bj][m][n], 0, 0, 0); } } \
        __builtin_amdgcn_s_setprio(0); } while (0)
#define PG8_WAIT_V(n) asm volatile("s_waitcnt vmcnt(" #n ")" ::: "memory")
#define PG8_WAIT_L(n) asm volatile("s_waitcnt lgkmcnt(" #n ")" ::: "memory")
#define PG8_WAIT_RLX() do { if (sr >= 32) PG8_WAIT_V(40); else if (sr >= 16) PG8_WAIT_V(24); else PG8_WAIT_V(16); } while (0)
#define PG8_BAR __builtin_amdgcn_s_barrier()
#define PG8_SCHED __builtin_amdgcn_sched_barrier(0)
    Unit cur, nxt; int ui = 0, sr = 8;
    if (!S.next(0, cur)) return;
    f32x4 acc[2][2][4][2];
#pragma unroll
    for (int a = 0; a < 2; ++a)
#pragma unroll
        for (int b = 0; b < 2; ++b)
#pragma unroll
            for (int m = 0; m < 4; ++m)
#pragma unroll
                for (int n = 0; n < 2; ++n) acc[a][b][m][n] = (f32x4){0.f, 0.f, 0.f, 0.f};
    int scA = Sched::sA, scB = Sched::sB;
    bf16x8 At[4][2], B0[2][2], B1[2][2];
    i32x8v At8[4], B08[2], B18[2];
    unsigned vc[2][2], vn[2][2];
    if constexpr (GA) S.a_offsets(cur, 0, vc);
    const char* cA = Abase + (size_t)cur.orow0 * lda;
    const char* cB = cur.Bp;
    PG8_STAGE(PG8_SB(0, 0), cB, voffB); PG8_STAGE(PG8_SB(0, 1), cB + hstepB, voffB); PG8_STAGE_AC(PG8_SA(0, 0), 0, 0); PG8_STAGE_AC(PG8_SA(0, 1), 1, 0);
    if (wr == 1) PG8_BAR;
    PG8_WAIT_V(2); PG8_BAR;
    PG8_STAGE(PG8_SB(1, 0), cB + kstep, voffB); PG8_STAGE_AC(PG8_SA(1, 0), 0, kstep); PG8_STAGE(PG8_SB(1, 1), cB + hstepB + kstep, voffB);
    PG8_WAIT_V(6); PG8_BAR;
    for (;;) {
        const bool has_next = S.next(ui + 1, nxt);
        if constexpr (GA) {
            if (has_next) S.a_offsets(nxt, ui + 1, vn);
            else {
#pragma unroll
                for (int h = 0; h < 2; ++h)
#pragma unroll
                    for (int j = 0; j < 2; ++j) vn[h][j] = vc[h][j];
            }
        }
        const char* nA = has_next ? Abase + (size_t)nxt.orow0 * lda : cA;
        const char* nB = has_next ? nxt.Bp : cB;
#define PG8_TRIP(RLX) do { \
            const bool last = (t == nt - 2); \
            if (HAS_MID) { if (t == midt) E.mid(acc, cur, wr, wc, fr, fq); } \
            const char* a2 = last ? nA : cA + (size_t)(t + 2) * kstep; const char* b2 = last ? nB : cB + (size_t)(t + 2) * kstep; \
            const char* b3 = b2 + kstep; \
            const char* ag2 = last ? Abase : Abase + (size_t)(t + 2) * kstep;        \
            unsigned v2[2][2]; \
            if constexpr (GA) { \
                _Pragma("unroll") for (int h = 0; h < 2; ++h) \
                _Pragma("unroll") for (int j = 0; j < 2; ++j) v2[h][j] = last ? vn[h][j] : vc[h][j]; \
            } \
              \
            PG8_LDB(B0, 0, 0); PG8_LDB(B1, 0, 1); PG8_SCHED; PG8_LDA(At, 0, 0); if (!(RLX)) PG8_STAGE_AC(PG8_SA(1, 1), 1, (size_t)(t + 1) * kstep); \
            if (RLX) PG8_WAIT_RLX(); else PG8_WAIT_V(8); PG8_WAIT_L(0); PG8_BAR; PG8_MMA(0, 0, At, B0); PG8_MMA(0, 1, At, B1); PG8_BAR; PG8_SCHED; \
              \
            PG8_LDA(At, 0, 1); PG8_STAGE(PG8_SB(0, 0), b2, voffB); PG8_STAGE(PG8_SB(0, 1), b2 + hstepB, voffB); PG8_STAGE_AN(PG8_SA(0, 0), 0, 0); \
            if (RLX) PG8_WAIT_RLX(); else PG8_WAIT_V(8); PG8_WAIT_L(0); PG8_BAR; PG8_MMA(1, 0, At, B0); PG8_MMA(1, 1, At, B1); PG8_BAR; PG8_SCHED; \
              \
            PG8_LDB(B0, 1, 0); PG8_LDB(B1, 1, 1); PG8_SCHED; PG8_LDA(At, 1, 0); PG8_STAGE_AN(PG8_SA(0, 1), 1, 0); \
            if (RLX) PG8_WAIT_RLX(); else PG8_WAIT_V(8); PG8_WAIT_L(0); PG8_BAR; PG8_MMA(0, 0, At, B0); PG8_MMA(0, 1, At, B1); PG8_BAR; PG8_SCHED; \
              \
            PG8_LDA(At, 1, 1); PG8_STAGE(PG8_SB(1, 0), b3, voffB); PG8_STAGE(PG8_SB(1, 1), b3 + hstepB, voffB); PG8_STAGE_AN(PG8_SA(1, 0), 0, kstep); \
            PG8_WAIT_V(8); PG8_WAIT_L(0); PG8_BAR; PG8_MMA(1, 0, At, B0); PG8_MMA(1, 1, At, B1); PG8_BAR; PG8_SCHED; \
        } while (0)
        int t = 0;
        if constexpr (RELAX) { if (ui > 0) { PG8_TRIP(1); t = 2; } }
        for (; t < nt; t += 2) { PG8_TRIP(0); }
#undef PG8_TRIP
        if (RELAX && has_next) {
            if constexpr (GA) { PG8_STAGE(PG8_SA(1, 1), Abase + kstep, vn[1]); } else { PG8_STAGE(PG8_SA(1, 1), nA + hstepA + kstep, voffA); }
            asm volatile("" ::: "memory"); PG8_SCHED;
        }
        if constexpr (ALIGN_EPI) { if (wr == 0) PG8_BAR; }
        if constexpr (Sched::FP8) {
            asm volatile("s_nop 15\n\ts_nop 15" : "+v"(acc[1][0][0][0]), "+v"(acc[1][0][0][1]), "+v"(acc[1][0][1][0]), "+v"(acc[1][0][1][1]), "+v"(acc[1][0][2][0]), "+v"(acc[1][0][2][1]), "+v"(acc[1][0][3][0]), "+v"(acc[1][0][3][1]));
            asm volatile("" : "+v"(acc[1][1][0][0]), "+v"(acc[1][1][0][1]), "+v"(acc[1][1][1][0]), "+v"(acc[1][1][1][1]), "+v"(acc[1][1][2][0]), "+v"(acc[1][1][2][1]), "+v"(acc[1][1][3][0]), "+v"(acc[1][1][3][1]));
        }
        E(acc, cur, wr, wc, fr, fq);
        asm volatile("" ::: "memory"); PG8_SCHED;
        if (!has_next) break;
        sr = E.vm_min(cur);
#pragma unroll
        for (int a = 0; a < 2; ++a)
#pragma unroll
            for (int b = 0; b < 2; ++b)
#pragma unroll
                for (int m = 0; m < 4; ++m)
#pragma unroll
                    for (int n = 0; n < 2; ++n) acc[a][b][m][n] = (f32x4){0.f, 0.f, 0.f, 0.f};
        cur = nxt; cA = nA; cB = nB; ++ui;
        if constexpr (GA) {
#pragma unroll
            for (int h = 0; h < 2; ++h)
#pragma unroll
                for (int j = 0; j < 2; ++j) vc[h][j] = vn[h][j];
        }
        if constexpr (ALIGN_EPI) { if (wr == 1) PG8_BAR; }
    }
    PG8_WAIT_V(0);
    if constexpr (!ALIGN_EPI) { if (wr == 0) PG8_BAR; }
    PG8_BAR;
#undef PG8_SA
#undef PG8_SB
#undef PG8_STAGE
#undef PG8_STAGE_AC
#undef PG8_STAGE_AN
#undef PG8_LDA
#undef PG8_LDB
#undef PG8_MMA
#undef PG8_WAIT_V
#undef PG8_WAIT_L
#undef PG8_WAIT_RLX
#undef PG8_BAR
#undef PG8_SCHED
}

#define PG8_FOR_ROWS(u) _Pragma("unroll") for (int ai = 0; ai < 2; ++ai) _Pragma("unroll") for (int m = 0; m < 4; ++m)
struct EpiInF {
    static constexpr bool PERM = true, PERM16 = false;
    unsigned char* ws; int pn_off;
    __device__ __forceinline__ void operator()(const f32x4 (&acc)[2][2][4][2], const Unit& u, int wr, int wc, int fr, int fq) const {
        const int pn = u.pn + pn_off; const float* rot = (const float*)(ws + WS_ROT);
        if (pn < 8) {
#pragma unroll
            for (int ai = 0; ai < 2; ++ai) {
                f32x4 rq[4][2];
#pragma unroll
                for (int m = 0; m < 4; ++m) { const int row = u.orow0 + ai * HALF + wr * 64 + m * 16 + fr, pos = row & (SEQ - 1);
                    const float* rp = rot + ((size_t)pos * 64 + ((wc * 32 + 8 * fq) >> 1)) * 2; rq[m][0] = *(const f32x4*)rp; rq[m][1] = *(const f32x4*)(rp + 4); }
                asm volatile("" ::: "memory");
                asm volatile("" : "+v"(rq[0][0]), "+v"(rq[0][1]), "+v"(rq[1][0]), "+v"(rq[1][1]), "+v"(rq[2][0]), "+v"(rq[2][1]), "+v"(rq[3][0]), "+v"(rq[3][1]));
#pragma unroll
                for (int m = 0; m < 4; ++m) { const int row = u.orow0 + ai * HALF + wr * 64 + m * 16 + fr;
                    bf16* dst = (bf16*)(ws + (pn < 4 ? WS_Q : WS_K)) + (size_t)row * 1024 + (pn & 3) * 256;
                    const f32x4 r0 = rq[m][0], r1 = rq[m][1];
#pragma unroll
                    for (int bj = 0; bj < 2; ++bj) {
                        const int cl = bj * HALF + wc * 32 + 8 * fq;
                        const f32x4 a = acc[ai][bj][m][0], b = acc[ai][bj][m][1];
                        f32x4 oa, ob;
                        oa[0] = a[0] * r0[0] - a[1] * r0[1]; oa[1] = a[0] * r0[1] + a[1] * r0[0];
                        oa[2] = a[2] * r0[2] - a[3] * r0[3]; oa[3] = a[2] * r0[3] + a[3] * r0[2];
                        ob[0] = b[0] * r1[0] - b[1] * r1[1]; ob[1] = b[0] * r1[1] + b[1] * r1[0];
                        ob[2] = b[2] * r1[2] - b[3] * r1[3]; ob[3] = b[2] * r1[3] + b[3] * r1[2];
                        *(u32x4*)(dst + cl) = pack8(oa, ob);
                    }
                }
                asm volatile("" ::: "memory");
            }
            return;
        }
        PG8_FOR_ROWS(u) {
            const int row = u.orow0 + ai * HALF + wr * 64 + m * 16 + fr;
            if (pn < 8) {
            } else if (pn < 20) {
                bf16* dst = (bf16*)(ws + (pn < 12 ? WS_V : pn < 16 ? WS_G : WS_CB)) + (size_t)row * 1024 + (pn & 3) * 256;
#pragma unroll
                for (int bj = 0; bj < 2; ++bj) {
                    const int cl = bj * HALF + wc * 32 + 8 * fq;
                    f32x4 a = acc[ai][bj][m][0], b = acc[ai][bj][m][1];
                    if (pn >= 12 && pn < 16) {
#pragma unroll
                        for (int j = 0; j < 4; ++j) { a[j] = silu_f(a[j]); b[j] = silu_f(b[j]); }
                    }
                    *(u32x4*)(dst + cl) = pack8(a, b);
                }
            } else if (pn < 28) {
                const int cl = wc * 32 + 8 * fq;
                const f32x4 a = acc[ai][0][m][0] * acc[ai][1][m][0], b = acc[ai][0][m][1] * acc[ai][1][m][1];
                *(u32x4*)((bf16*)(ws + WS_UP) + (size_t)row * 1024 + (pn - 20) * 128 + cl) = pack8(a, b);
            } else {
                bf16* dst = (bf16*)(ws + (pn < 36 ? WS_GR : WS_GC)) + (size_t)row * 2048 + (pn < 36 ? pn - 28 : pn - 36) * 256;
#pragma unroll
                for (int bj = 0; bj < 2; ++bj) {
                    const int cl = bj * HALF + wc * 32 + 8 * fq;
                    f32x4 a = acc[ai][bj][m][0], b = acc[ai][bj][m][1];
#pragma unroll
                    for (int j = 0; j < 4; ++j) { a[j] = sigmoid_f(a[j]); b[j] = sigmoid_f(b[j]); }
                    *(u32x4*)(dst + cl) = pack8(a, b);
                }
            }
        }
    }
    __device__ __forceinline__ void mid(f32x4 (&)[2][2][4][2], const Unit&, int, int, int, int) const {}
    __device__ __forceinline__ int vm_min(const Unit& u) const { const int pn = u.pn + pn_off; return (pn >= 20 && pn < 28) ? 8 : 16; }
};
struct EpiMergeF {
    static constexpr bool PERM = true, PERM16 = false;
    bf16* M; const bf16 *GR, *GC;
    __device__ __forceinline__ void mid(f32x4 (&acc)[2][2][4][2], const Unit& u, int wr, int wc, int fr, int fq) const {
        unsigned base = (unsigned)((u.orow0 + wr * 64 + fr) * 2048 + u.pn * BM + wc * 32 + 8 * fq);
        asm volatile("" : "+v"(base));
#pragma unroll
        for (int ai = 0; ai < 2; ++ai) {
            u32x4 gr[8], gc[8];
#pragma unroll
            for (int m = 0; m < 4; ++m)
#pragma unroll
                for (int bj = 0; bj < 2; ++bj) { const unsigned o = base + (unsigned)((ai * HALF + m * 16) * 2048 + bj * HALF); gr[m * 2 + bj] = *(const u32x4*)(GR + o); gc[m * 2 + bj] = *(const u32x4*)(GC + o); }
            asm volatile("" ::: "memory");
            asm volatile("" : "+v"(gr[0]), "+v"(gr[1]), "+v"(gr[2]), "+v"(gr[3]), "+v"(gr[4]), "+v"(gr[5]), "+v"(gr[6]), "+v"(gr[7]));
            asm volatile("" : "+v"(gc[0]), "+v"(gc[1]), "+v"(gc[2]), "+v"(gc[3]), "+v"(gc[4]), "+v"(gc[5]), "+v"(gc[6]), "+v"(gc[7]));
#pragma unroll
            for (int m = 0; m < 4; ++m) {
#pragma unroll
                for (int bj = 0; bj < 2; ++bj) {
                    f32x4 ra, rb, ca, cb; unpack8(gr[m * 2 + bj], ra, rb); unpack8(gc[m * 2 + bj], ca, cb);
#pragma unroll
                    for (int j = 0; j < 4; ++j) { acc[ai][bj][m][0][j] *= ra[j] * __builtin_amdgcn_rcpf(fmaxf(ca[j], 1e-18f)); acc[ai][bj][m][1][j] *= rb[j] * __builtin_amdgcn_rcpf(fmaxf(cb[j], 1e-18f)); }
                }
                asm volatile("" : "+v"(acc[ai][0][m][0]), "+v"(acc[ai][0][m][1]), "+v"(acc[ai][1][m][0]), "+v"(acc[ai][1][m][1]) :: "memory");
            }
        }
    }
    __device__ __forceinline__ void operator()(const f32x4 (&acc)[2][2][4][2], const Unit& u, int wr, int wc, int fr, int fq) const {
        const size_t o0 = (size_t)(u.orow0 + wr * 64 + fr) * 2048 + u.pn * BM + wc * 32 + 8 * fq;
        u32x4 gc[16];
#pragma unroll
        for (int t = 0; t < 16; ++t) gc[t] = *(const u32x4*)(GC + o0 + (size_t)(((t >> 3) * HALF + ((t >> 1) & 3) * 16) * 2048 + (t & 1) * HALF));
        asm volatile("" ::: "memory");
        asm volatile("" : "+v"(gc[0]), "+v"(gc[1]), "+v"(gc[2]), "+v"(gc[3]), "+v"(gc[4]), "+v"(gc[5]), "+v"(gc[6]), "+v"(gc[7]));
        asm volatile("" : "+v"(gc[8]), "+v"(gc[9]), "+v"(gc[10]), "+v"(gc[11]), "+v"(gc[12]), "+v"(gc[13]), "+v"(gc[14]), "+v"(gc[15]));
#pragma unroll
        for (int t = 0; t < 16; ++t) { const int ai = t >> 3, m = (t >> 1) & 3, bj = t & 1;
            f32x4 ca, cb; unpack8(gc[t], ca, cb);
#pragma unroll
            for (int j = 0; j < 4; ++j) { ca[j] = fmaxf(ca[j], 1e-18f); cb[j] = fmaxf(cb[j], 1e-18f); }
            *(u32x4*)(M + o0 + (size_t)((ai * HALF + m * 16) * 2048 + bj * HALF)) = pack8(acc[ai][bj][m][0] * ca, acc[ai][bj][m][1] * cb);
        }
    }
    __device__ __forceinline__ int vm_min(const Unit&) const { return 32; }
};
struct EpiRes1F {
    static constexpr bool PERM = false, PERM16 = false;
    const float* x; float* o; const float* mod;
    __device__ __forceinline__ void operator()(const f32x4 (&acc)[2][2][4][2], const Unit& u, int wr, int wc, int fr, int fq) const {
        const int b = u.orow0 / SEQ;
        f32x4 g[2][2];
#pragma unroll
        for (int bj = 0; bj < 2; ++bj)
#pragma unroll
            for (int n = 0; n < 2; ++n) g[bj][n] = *(const f32x4*)(mod + b * 6 * D + 2 * D + u.pn * BM + bj * HALF + wc * 32 + n * 16 + 4 * fq);
        f32x4 xq[2][4];
        const size_t i0 = (size_t)(u.orow0 + wr * 64 + fr) * 2048 + u.pn * BM + wc * 32 + 4 * fq;
#define RES1_LOAD(Q, AI, M) do { _Pragma("unroll") for (int bj = 0; bj < 2; ++bj) _Pragma("unroll") for (int n = 0; n < 2; ++n) \
            xq[Q][bj * 2 + n] = *(const f32x4*)(x + i0 + (size_t)((AI) * HALF + (M) * 16) * 2048 + bj * HALF + n * 16); } while (0)
        RES1_LOAD(0, 0, 0);
#pragma unroll
        for (int t = 0; t < 8; ++t) {
            const int ai = t >> 2, m = t & 3, q = t & 1;
            if (t < 7) RES1_LOAD(q ^ 1, (t + 1) >> 2, (t + 1) & 3);
            asm volatile("" ::: "memory");
            asm volatile("" : "+v"(xq[q][0]), "+v"(xq[q][1]), "+v"(xq[q][2]), "+v"(xq[q][3]));
#pragma unroll
            for (int bj = 0; bj < 2; ++bj)
#pragma unroll
                for (int n = 0; n < 2; ++n) *(f32x4*)(o + i0 + (size_t)(ai * HALF + m * 16) * 2048 + bj * HALF + n * 16) = xq[q][bj * 2 + n] + g[bj][n] * acc[ai][bj][m][n];
            asm volatile("" ::: "memory");
        }
#undef RES1_LOAD
    }
    __device__ __forceinline__ void mid(f32x4 (&)[2][2][4][2], const Unit&, int, int, int, int) const {}
    __device__ __forceinline__ int vm_min(const Unit&) const { return 32; }
};
constexpr int MOE_LDS_CNT = 131072 + 512 + 2560 + 12288 + 128;
constexpr int MOE_LDS_BASE = 131072, MOE_LDS_RT2E = 131072 + 512, MOE_LDS_ROWMAP = 131072 + 512 + 2560, MOE_MAXU = 12, MOE_LDS_UTAB = 131072 + 512 + 2560 + 12288, MOE_UTAB_N = 32;
__device__ __forceinline__ int moe_base_tables(const unsigned* ctl, LAS unsigned char* lds) {
    LAS int* base = (LAS int*)(lds + MOE_LDS_BASE); LAS int* cnt = (LAS int*)(lds + MOE_LDS_CNT);
    int tidl = threadIdx.x; asm volatile("" : "+v"(tidl));
    if (tidl < 64) {
        const int e = tidl, c = (int)ctl[CW_CNT + 64 * e], pad = (c + 255) & ~255;
        int incl = pad;
#pragma unroll
        for (int o = 1; o < 64; o <<= 1) { const int v = __shfl_up(incl, o); if (e >= o) incl += v; }
        base[e] = incl - pad; cnt[e] = c; if (e == 63) base[64] = incl;
    }
    __syncthreads();
    return __builtin_amdgcn_readfirstlane(base[64]);
}
template <bool GATHER, bool F8, int SA_, int SB_> struct MoeSched {
    const bf16* A; int lda; int ldb; int K; int nM, nN, G, c; int total_rt;
    const char* Brouted; size_t estride; const char* Bshared; LAS unsigned char* lds;
    __device__ __forceinline__ void setup(const int* ltok) const {
        LAS int* base = (LAS int*)(lds + MOE_LDS_BASE); LAS int* cnt = (LAS int*)(lds + MOE_LDS_CNT); LAS int* rt2e = (LAS int*)(lds + MOE_LDS_RT2E); LAS int* rowmap = (LAS int*)(lds + MOE_LDS_ROWMAP);
        for (int rt = threadIdx.x; rt < total_rt; rt += NTHREADS) { int e = 0; while (e < NE - 1 && base[e + 1] <= rt * 256) ++e; rt2e[rt] = e; }
        LAS int* utab = (LAS int*)(lds + MOE_LDS_UTAB);
        if (threadIdx.x < MOE_UTAB_N) { int pm, pn; int ut = -1;
            if (static_tile((int)threadIdx.x, G, c, nM, nN, pm, pn)) { const int c0 = pm * 64 / nM, c1 = (pm + 1) * 64 / nM; pm = (c1 > c0) ? total_rt + c0 : pm - c0; ut = pm | (pn << 16); }
            utab[threadIdx.x] = ut; }
        __syncthreads();
        if (GATHER) {
            for (int i = 0; i < MOE_MAXU; ++i) { const int ut = utab[i]; if (ut < 0) break; const int pm = ut & 0xffff;
                if (threadIdx.x < 256) { int tok;
                    if (pm < total_rt) { const int e = rt2e[pm], pos = pm * 256 + (int)threadIdx.x - base[e]; tok = pos < cnt[e] ? ltok[(size_t)e * T + pos] : 0; }
                    else tok = (pm - total_rt) * 256 + (int)threadIdx.x;
                    rowmap[i * 256 + threadIdx.x] = tok; } }
        }
        asm volatile("s_waitcnt vmcnt(0) lgkmcnt(0)" ::: "memory");
        __syncthreads();
    }
    __device__ __forceinline__ bool next(int i, Unit& u) const {
        if (i >= MOE_UTAB_N) return false;
        const int ut = __builtin_amdgcn_readfirstlane(((const LAS int*)(lds + MOE_LDS_UTAB))[i]); if (ut < 0) return false;
        const int pm = ut & 0xffff, pn = ut >> 16;
        u.pm = pm; u.pn = pn;
        if (pm < total_rt) { const LAS int* rt2e = (const LAS int*)(lds + MOE_LDS_RT2E); const int e = __builtin_amdgcn_readfirstlane(rt2e[pm]);
            u.kind = 0; u.e = e; u.orow0 = pm * BM; u.Bp = Brouted + (size_t)e * estride + (size_t)pn * BM * ldb; }
        else { u.kind = 1; u.e = 0; u.orow0 = CAP + (pm - total_rt) * BM; u.Bp = Bshared + (size_t)pn * BM * ldb; }
        return true;
    }
    static constexpr bool GATHER_A = GATHER, FP8 = F8; static constexpr int sA = SA_, sB = SB_;
    __device__ __forceinline__ void a_offsets(const Unit& u, int i, unsigned (&v)[2][2]) const {
        const LAS int* rowmap = (const LAS int*)(lds + MOE_LDS_ROWMAP);
#pragma unroll
        for (int j = 0; j < 2; ++j) { int R, C; stage_rc((int)threadIdx.x * 16 + j * 8192, R, C);
#pragma unroll
            for (int h = 0; h < 2; ++h) v[h][j] = (unsigned)(rowmap[i * 256 + h * HALF + R] * lda + C * 2); }
    }
};
struct EpiGUF {
    static constexpr bool PERM = true, PERM16 = false;
    unsigned char* ACT;
    __device__ __forceinline__ void operator()(const f32x4 (&acc)[2][2][4][2], const Unit& u, int wr, int wc, int fr, int fq) const {
        PG8_FOR_ROWS(u) {
            const int row = u.orow0 + ai * HALF + wr * 64 + m * 16 + fr;
            f32x4 a, b;
#pragma unroll
            for (int j = 0; j < 4; ++j) { a[j] = 4.f * silu_f(acc[ai][0][m][0][j]) * acc[ai][1][m][0][j]; b[j] = 4.f * silu_f(acc[ai][0][m][1][j]) * acc[ai][1][m][1][j]; }
            *(unsigned long long*)(ACT + (size_t)row * 512 + u.pn * 128 + wc * 32 + 8 * fq) = (unsigned long long)pk4_fp8(a[0], a[1], a[2], a[3]) | ((unsigned long long)pk4_fp8(b[0], b[1], b[2], b[3]) << 32);
        }
    }
    __device__ __forceinline__ void mid(f32x4 (&)[2][2][4][2], const Unit&, int, int, int, int) const {}
    __device__ __forceinline__ int vm_min(const Unit&) const { return 8; }
};
struct EpiDownF {
    static constexpr bool PERM = false, PERM16 = true;
    unsigned char* Y; const float* lw; LAS unsigned char* lds;
    __device__ __forceinline__ void operator()(const f32x4 (&acc)[2][2][4][2], const Unit& u, int wr, int wc, int fr, int fq) const {
        const int ebase = ((const LAS int*)(lds + MOE_LDS_BASE))[u.e], ecnt = ((const LAS int*)(lds + MOE_LDS_CNT))[u.e];
        PG8_FOR_ROWS(u) {
            const int row = u.orow0 + ai * HALF + wr * 64 + m * 16 + fr, pos = row - ebase; const float w = (u.kind == 0) ? (pos < ecnt ? 16.f * lw[(size_t)u.e * T + pos] : 0.f) : 16.f;
            u32x4 o;
            { const f32x4 a = acc[ai][0][m][0] * w, b = acc[ai][0][m][1] * w; o.x = pk4_fp8(a[0], a[1], a[2], a[3]); o.y = pk4_fp8(b[0], b[1], b[2], b[3]); }
            { const f32x4 a = acc[ai][1][m][0] * w, b = acc[ai][1][m][1] * w; o.z = pk4_fp8(a[0], a[1], a[2], a[3]); o.w = pk4_fp8(b[0], b[1], b[2], b[3]); }
            *(u32x4*)(Y + (size_t)row * 2048 + u.pn * BM + wc * 64 + 16 * fq) = o;
        }
    }
    __device__ __forceinline__ void mid(f32x4 (&)[2][2][4][2], const Unit&, int, int, int, int) const {}
    __device__ __forceinline__ int vm_min(const Unit&) const { return 8; }
};
}

struct EpiIn {
    bf16 *Q, *Kk, *V, *G, *CB, *UP, *GR, *GC; const float2* rot;
    __device__ __forceinline__ void operator()(int row, int col, float v) const {
        const float p1 = __shfl_xor(v, 1), p4 = __shfl_xor(v, 4);
        if (col < 2048) {
            const int f = (col & 127) >> 1, pos = row & (SEQ - 1);
            const float2 cs = rot[pos * 64 + f];
            const float o = (col & 1) ? (p1 * cs.y + v * cs.x) : (v * cs.x - p1 * cs.y);
            if (col < 1024) Q[(size_t)row * 1024 + col] = f2bf(o); else Kk[(size_t)row * 1024 + col - 1024] = f2bf(o);
        } else if (col < 3072) V[(size_t)row * 1024 + col - 2048] = f2bf(v);
        else if (col < 4096) G[(size_t)row * 1024 + col - 3072] = f2bf(silu_f(v));
        else if (col < 5120) CB[(size_t)row * 1024 + col - 4096] = f2bf(v);
        else if (col < 7168) { const int l = col - 5120; if ((l & 7) < 4) UP[(size_t)row * 1024 + (l >> 3) * 4 + (l & 3)] = f2bf(v * p4); }
        else if (col < 9216) GR[(size_t)row * 2048 + col - 7168] = f2bf(sigmoid_f(v));
        else GC[(size_t)row * 2048 + col - 9216] = f2bf(sigmoid_f(v));
    }
};
struct EpiMergeA { bf16* M; const bf16* GR; __device__ __forceinline__ void operator()(int row, int col, float v) const { const size_t i = (size_t)row * 2048 + col; M[i] = f2bf(bf2f(GR[i]) * v); } };
struct EpiMergeB { bf16* M; const bf16* GC; __device__ __forceinline__ void operator()(int row, int col, float v) const { const size_t i = (size_t)row * 2048 + col; M[i] = f2bf(bf2f(M[i]) + bf2f(GC[i]) * v); } };
struct EpiRes1 { const float* x; float* o; const float* mod; __device__ __forceinline__ void operator()(int row, int col, float v) const {
    const size_t i = (size_t)row * 2048 + col; const int b = row / SEQ; o[i] = x[i] + mod[b * 6 * D + 2 * D + col] * v; } };
struct EpiGU { bf16* ACT; __device__ __forceinline__ void operator()(int row, int col, float v) const {
    const float p4 = __shfl_xor(v, 4); if ((col & 7) < 4) ACT[(size_t)row * 512 + (col >> 3) * 4 + (col & 3)] = f2bf(silu_f(v) * p4); } };
struct EpiDown { bf16* Y; const float* rw; __device__ __forceinline__ void operator()(int row, int col, float v) const { Y[(size_t)row * 2048 + col] = f2bf(rw[row] * v); } };
struct EpiDownS { float* o; const float* mod; __device__ __forceinline__ void operator()(int row, int col, float v) const {
    const size_t i = (size_t)row * 2048 + col; const int b = row / SEQ; o[i] += mod[b * 6 * D + 5 * D + col] * v; } };

template <class Epi>
__device__ __forceinline__ void gemm_simple(const GemmS& g, int M, int N, LAS unsigned char* lds, const Epi& E, int bid, int nb) {
    const int tm = M / 128, tn = N / 256;
    for (int t = bid; t < tm * tn; t += nb) { const int pm = t / tn, pn = t % tn; gemm_tile_simple(g, pm * 128, pn * 256, lds, E); }
}

__device__ __forceinline__ float log_sigmoid_f(float x) { return -log1pf(expf(-x)); }
__device__ __forceinline__ bf16x8 frag_row(const LAS unsigned char* img, int r, int chunk) { return *(const LAS bf16x8*)(img + r * 256 + ((chunk ^ (r & 15)) << 4)); }
__device__ __forceinline__ bf16x8 frag_tr(const LAS unsigned char* img, int x, int chunk) { return *(const LAS bf16x8*)(img + x * 256 + ((chunk ^ ((x + (x >> 3)) & 15)) << 4)); }
__device__ __forceinline__ void stage_row_img(LAS unsigned char* img, const bf16* src, int ld) {
#pragma unroll
    for (int r = 0; r < 4; ++r) { const int p = threadIdx.x + NTHREADS * r, row = p >> 4, c = p & 15;
        const u32x4 v = *(const u32x4*)(src + (size_t)row * ld + c * 8);
        *(LAS u32x4*)(img + row * 256 + ((c ^ (row & 15)) << 4)) = v; }
}
__device__ __forceinline__ void stage_tr_img2(LAS unsigned char* img, const bf16* src, int ld) {
#pragma unroll 1
    for (int r = 0; r < 2; ++r) { const int p = threadIdx.x + NTHREADS * r, j = (p >> 4) * 2, c = p & 15;
        const u32x4 v0 = *(const u32x4*)(src + (size_t)j * ld + c * 8), v1 = *(const u32x4*)(src + (size_t)(j + 1) * ld + c * 8);
        const unsigned w0[4] = {v0.x, v0.y, v0.z, v0.w}, w1[4] = {v1.x, v1.y, v1.z, v1.w};
#pragma unroll
        for (int i = 0; i < 8; ++i) { const int x = 8 * c + i;
            const unsigned lo = (i & 1) ? (w0[i >> 1] >> 16) : (w0[i >> 1] & 0xffffu), hi = (i & 1) ? (w1[i >> 1] & 0xffff0000u) : (w1[i >> 1] << 16);
            *(LAS unsigned*)(img + x * 256 + (((j >> 3) ^ ((x + (x >> 3)) & 15)) << 4) + (j & 7) * 2) = lo | hi; }
    }
}
__device__ __forceinline__ void ph_kv_conv(const Params& p, LAS unsigned char* lds, int bid, int nb) {
    unsigned char* ws = p.ws;
    const bf16* Kk = (const bf16*)(ws + WS_K); const bf16* V = (const bf16*)(ws + WS_V);
    const int lane = threadIdx.x & 63, w = threadIdx.x >> 6, r16 = lane & 15, q = lane >> 4;
    LAS unsigned char* TK = lds; LAS unsigned char* TV = lds + 32768;
#pragma unroll 1
    for (int item = bid; item < BATCH * NH * NCH; item += nb) {
        const int n = item % NCH, h = (item / NCH) % NH, b = item / (NCH * NH);
        const float lgf = log_sigmoid_f(p.dec_f[h]), lgb = log_sigmoid_f(p.dec_b[h]);
        const size_t row0 = (size_t)b * SEQ + n * CH;
        stage_tr_img2(TK, Kk + row0 * 1024 + h * 128, 1024);
        stage_tr_img2(TV, V + row0 * 1024 + h * 128, 1024);
        lds_barrier();
        f32x4 af[8], ab[8];
#pragma unroll
        for (int d = 0; d < 8; ++d) { af[d] = (f32x4){0.f, 0.f, 0.f, 0.f}; ab[d] = (f32x4){0.f, 0.f, 0.f, 0.f}; }
#pragma unroll
        for (int ks = 0; ks < 4; ++ks) {
            union { bf16x8 v; unsigned u[4]; } raw, sf, sb; raw.v = frag_tr(TV, 16 * w + r16, 4 * ks + q);
            const int j0 = 32 * ks + 8 * q;
#pragma unroll
            for (int i = 0; i < 4; ++i) {
                const float lo = __uint_as_float(raw.u[i] << 16), hi = __uint_as_float(raw.u[i] & 0xffff0000u);
                const float wf0 = __expf(lgf * (float)(127 - (j0 + 2 * i))), wf1 = __expf(lgf * (float)(127 - (j0 + 2 * i + 1)));
                const float wb0 = __expf(lgb * (float)(j0 + 2 * i)), wb1 = __expf(lgb * (float)(j0 + 2 * i + 1));
                sf.u[i] = pg8::cvt_pk_bf16(lo * wf0, hi * wf1); sb.u[i] = pg8::cvt_pk_bf16(lo * wb0, hi * wb1);
            }
            const bf16x8 vf = sf.v, vb = sb.v;
#pragma unroll
            for (int d = 0; d < 8; ++d) { const bf16x8 a = frag_tr(TK, 16 * d + r16, 4 * ks + q);
                af[d] = __builtin_amdgcn_mfma_f32_16x16x32_bf16(a, vf, af[d], 0, 0, 0); ab[d] = __builtin_amdgcn_mfma_f32_16x16x32_bf16(a, vb, ab[d], 0, 0, 0); }
        }
        bf16* of = (bf16*)(ws + WS_KVF) + ((size_t)item * 128 + 16 * w + r16) * 128 + 4 * q;
        bf16* ob = (bf16*)(ws + WS_KVB) + ((size_t)item * 128 + 16 * w + r16) * 128 + 4 * q;
#pragma unroll
        for (int d = 0; d < 8; ++d) {
            *(unsigned long long*)(of + 16 * d) = (unsigned long long)pg8::cvt_pk_bf16(af[d][0], af[d][1]) | ((unsigned long long)pg8::cvt_pk_bf16(af[d][2], af[d][3]) << 32);
            *(unsigned long long*)(ob + 16 * d) = (unsigned long long)pg8::cvt_pk_bf16(ab[d][0], ab[d][1]) | ((unsigned long long)pg8::cvt_pk_bf16(ab[d][2], ab[d][3]) << 32);
        }
        lds_barrier();
    }
    const bf16* CB = (const bf16*)(ws + WS_CB); const bf16* UP = (const bf16*)(ws + WS_UP); bf16* ACAT = (bf16*)(ws + WS_ACAT);
    {
        const size_t i00 = (size_t)bid * NTHREADS + threadIdx.x, istride = (size_t)nb * NTHREADS, itotal = (size_t)T * DCONV / 8;
        const int c = (int)(i00 & 127) * 8;
        const f32x4 w0a = *(const f32x4*)(p.conv_w + c), w0b = *(const f32x4*)(p.conv_w + c + 4), w1a = *(const f32x4*)(p.conv_w + 1024 + c), w1b = *(const f32x4*)(p.conv_w + 1024 + c + 4),
                    w2a = *(const f32x4*)(p.conv_w + 2048 + c), w2b = *(const f32x4*)(p.conv_w + 2048 + c + 4);
        const u32x4 zero = (u32x4){0u, 0u, 0u, 0u};
        for (size_t ib = i00; ib < itotal; ib += 4 * istride) {
            u32x4 u0[4], u1[4], u2[4], cb[4];
#pragma unroll
            for (int q = 0; q < 4; ++q) { const size_t i = ib + q * istride; const bool ok = i < itotal; const size_t t = ok ? (i >> 7) : 0; const int pos = (int)(t & (SEQ - 1));
                u1[q] = *(const u32x4*)(UP + t * 1024 + c); cb[q] = *(const u32x4*)(CB + t * 1024 + c);
                u0[q] = pos > 0 ? *(const u32x4*)(UP + (t - 1) * 1024 + c) : zero; u2[q] = pos < SEQ - 1 ? *(const u32x4*)(UP + (t + 1) * 1024 + c) : zero; }
            asm volatile("" ::: "memory");
            asm volatile("" : "+v"(u0[0]), "+v"(u0[1]), "+v"(u0[2]), "+v"(u0[3]), "+v"(u1[0]), "+v"(u1[1]), "+v"(u1[2]), "+v"(u1[3]));
            asm volatile("" : "+v"(u2[0]), "+v"(u2[1]), "+v"(u2[2]), "+v"(u2[3]), "+v"(cb[0]), "+v"(cb[1]), "+v"(cb[2]), "+v"(cb[3]));
#pragma unroll
            for (int q = 0; q < 4; ++q) { const size_t i = ib + q * istride; if (i < itotal) { const size_t t = i >> 7;
                f32x4 a0, b0, a1, b1, a2, b2, ac, bc; pg8::unpack8(u0[q], a0, b0); pg8::unpack8(u1[q], a1, b1); pg8::unpack8(u2[q], a2, b2); pg8::unpack8(cb[q], ac, bc);
                const f32x4 ya = ac * (w0a * a0 + w1a * a1 + w2a * a2), yb = bc * (w0b * b0 + w1b * b1 + w2b * b2);
                *(u32x4*)(ACAT + t * 2048 + 1024 + c) = pg8::pack8(ya, yb); } }
        }
    }
}

__device__ __forceinline__ bf16x8 scale_frag(const bf16x8& f, float sc) {
    union { bf16x8 v; unsigned u[4]; } in, out; in.v = f;
#pragma unroll
    for (int i = 0; i < 4; ++i) out.u[i] = pg8::cvt_pk_bf16(__uint_as_float(in.u[i] << 16) * sc, __uint_as_float(in.u[i] & 0xffff0000u) * sc);
    return out.v;
}
__device__ __forceinline__ void ret_state_sum(const bf16* KV, int first, int count, float lg, bool fwd, LAS unsigned char* img) {
    f32x4 acc[4][2];
#pragma unroll
    for (int r = 0; r < 4; ++r) { acc[r][0] = (f32x4){0.f, 0.f, 0.f, 0.f}; acc[r][1] = (f32x4){0.f, 0.f, 0.f, 0.f}; }
    const float step = lg * 128.f;
    int maxd = (step < -1e-6f) ? (int)(-16.2f / step) : 1024;
    int m0 = 0, m1 = count;
    if (fwd) { if (count - 1 - maxd > 0) m0 = count - 1 - maxd; } else { if (maxd + 1 < count) m1 = maxd + 1; }
    const bf16* base = KV + (size_t)first * 128 * 128 + (size_t)threadIdx.x * 8;
    int m = m0;
    for (; m + 1 < m1; m += 2) {
        u32x4 v[2][4];
#pragma unroll
        for (int u = 0; u < 2; ++u)
#pragma unroll
            for (int r = 0; r < 4; ++r) v[u][r] = *(const u32x4*)(base + (size_t)(m + u) * 128 * 128 + NTHREADS * 8 * r);
#pragma unroll
        for (int u = 0; u < 2; ++u) { const float fac = __expf(step * (float)(fwd ? (count - 1 - (m + u)) : (m + u)));
#pragma unroll
            for (int r = 0; r < 4; ++r) { f32x4 a, b2; pg8::unpack8(v[u][r], a, b2); acc[r][0] += a * fac; acc[r][1] += b2 * fac; } }
    }
    if (m < m1) { const float fac = __expf(step * (float)(fwd ? (count - 1 - m) : m));
        u32x4 v[4];
#pragma unroll
        for (int r = 0; r < 4; ++r) v[r] = *(const u32x4*)(base + (size_t)m * 128 * 128 + NTHREADS * 8 * r);
#pragma unroll
        for (int r = 0; r < 4; ++r) { f32x4 a, b2; pg8::unpack8(v[r], a, b2); acc[r][0] += a * fac; acc[r][1] += b2 * fac; } }
#pragma unroll
    for (int r = 0; r < 4; ++r) { const int pidx = threadIdx.x + NTHREADS * r, e = pidx >> 4, c = pidx & 15;
        *(LAS u32x4*)(img + e * 256 + ((c ^ (e & 15)) << 4)) = pg8::pack8(acc[r][0], acc[r][1]); }
}
__device__ __forceinline__ void ph_ret_out(const Params& p, LAS unsigned char* lds, int bid, int nb) {
    unsigned char* ws = p.ws;
    const bf16* Q = (const bf16*)(ws + WS_Q); const bf16* Kk = (const bf16*)(ws + WS_K); const bf16* V = (const bf16*)(ws + WS_V); const bf16* G = (const bf16*)(ws + WS_G);
    const bf16* KVF = (const bf16*)(ws + WS_KVF); const bf16* KVB = (const bf16*)(ws + WS_KVB); bf16* ACAT = (bf16*)(ws + WS_ACAT);
    const int lane = threadIdx.x & 63, w = threadIdx.x >> 6, r16_ = lane & 15, q_ = lane >> 4;
    LAS unsigned char* QI = lds; LAS unsigned char* KI = lds + 32768; LAS unsigned char* TV = lds + 65536; LAS unsigned char* PI = lds + 98304;
#pragma unroll 1
    for (int item = bid; item < BATCH * NH * NCH; item += nb) {
        const int n = item % NCH, b = item / (NCH * NH), h = ((item / NCH) + item / nb) % NH, it2 = (b * NH + h) * NCH + n;
        const float lgf = log_sigmoid_f(p.dec_f[h]), lgb = log_sigmoid_f(p.dec_b[h]);
        const size_t row0 = (size_t)b * SEQ + n * CH;
        stage_row_img(QI, Q + row0 * 1024 + h * 128, 1024);
        stage_row_img(KI, Kk + row0 * 1024 + h * 128, 1024);
        stage_tr_img2(TV, V + row0 * 1024 + h * 128, 1024);
        lds_barrier();
        int r16 = r16_, q = q_;
        asm volatile("" : "+v"(r16), "+v"(q));
        int iq = 16 * w + r16;
        asm volatile("" : "+v"(iq));
#pragma unroll
        for (int jb = 0; jb < 8; ++jb) {
            f32x4 sacc = (f32x4){0.f, 0.f, 0.f, 0.f};
#pragma unroll
            for (int ks = 0; ks < 4; ++ks) sacc = __builtin_amdgcn_mfma_f32_16x16x32_bf16(frag_row(KI, 16 * jb + r16, 4 * ks + q), frag_row(QI, iq, 4 * ks + q), sacc, 0, 0, 0);
            float pv[4];
#pragma unroll
            for (int rr = 0; rr < 4; ++rr) { const int jj = 16 * jb + 4 * q + rr; const float df = (float)(iq - jj);
                pv[rr] = sacc[rr] * ((iq >= jj) ? __expf(lgf * df) : __expf(-lgb * df)); }
            *(LAS unsigned long long*)(PI + iq * 256 + (((2 * jb + (q >> 1)) ^ (iq & 15)) << 4) + (q & 1) * 8) =
                (unsigned long long)pg8::cvt_pk_bf16(pv[0], pv[1]) | ((unsigned long long)pg8::cvt_pk_bf16(pv[2], pv[3]) << 32);
        }
        lds_barrier();
        ret_state_sum(KVF, it2 - n, n, lgf, true, KI);
        lds_barrier();
        f32x4 o1[8];
#pragma unroll
        for (int e = 0; e < 8; ++e) o1[e] = (f32x4){0.f, 0.f, 0.f, 0.f};
        {
            const float sf = __expf(lgf * (float)(iq + 1));
#pragma unroll
            for (int ks = 0; ks < 4; ++ks) {
                const bf16x8 pf = frag_row(PI, iq, 4 * ks + q), qs = scale_frag(frag_row(QI, iq, 4 * ks + q), sf);
#pragma unroll
                for (int e = 0; e < 8; ++e) { o1[e] = __builtin_amdgcn_mfma_f32_16x16x32_bf16(frag_tr(TV, 16 * e + r16, 4 * ks + q), pf, o1[e], 0, 0, 0);
                    o1[e] = __builtin_amdgcn_mfma_f32_16x16x32_bf16(frag_row(KI, 16 * e + r16, 4 * ks + q), qs, o1[e], 0, 0, 0); }
            }
        }
        lds_barrier();
        ret_state_sum(KVB, it2 + 1, NCH - 1 - n, lgb, false, TV);
        lds_barrier();
        {
            const float sb = __expf(lgb * (float)(128 - iq));
#pragma unroll
            for (int ks = 0; ks < 4; ++ks) {
                const bf16x8 qs = scale_frag(frag_row(QI, iq, 4 * ks + q), sb);
#pragma unroll
                for (int e = 0; e < 8; ++e) o1[e] = __builtin_amdgcn_mfma_f32_16x16x32_bf16(frag_row(TV, 16 * e + r16, 4 * ks + q), qs, o1[e], 0, 0, 0);
            }
        }
        float ss = 0.f;
#pragma unroll
        for (int e = 0; e < 8; ++e) ss += (o1[e][0] * o1[e][0] + o1[e][1] * o1[e][1]) + (o1[e][2] * o1[e][2] + o1[e][3] * o1[e][3]);
        ss += __shfl_xor(ss, 16); ss += __shfl_xor(ss, 32);
        const float rstd = rsqrtf(ss * (1.f / 128.f) + EPS);
#pragma unroll
        for (int e = 0; e < 8; ++e) { const int col = h * 128 + 16 * e + 4 * q;
            const unsigned long long gq = *(const unsigned long long*)(G + (row0 + iq) * 1024 + col);
            const f32x4 wv = *(const f32x4*)(p.ret_norm_w + col);
            const float g0 = __uint_as_float((unsigned)(gq & 0xffffull) << 16), g1 = __uint_as_float((unsigned)((gq >> 16) & 0xffffull) << 16),
                        g2 = __uint_as_float((unsigned)((gq >> 32) & 0xffffull) << 16), g3 = __uint_as_float((unsigned)(gq >> 48) << 16);
            *(unsigned long long*)(ACAT + (row0 + iq) * 2048 + col) = (unsigned long long)pg8::cvt_pk_bf16(g0 * o1[e][0] * rstd * wv[0], g1 * o1[e][1] * rstd * wv[1]) |
                ((unsigned long long)pg8::cvt_pk_bf16(g2 * o1[e][2] * rstd * wv[2], g3 * o1[e][3] * rstd * wv[3]) << 32); }
        lds_barrier();
    }
}

__device__ __forceinline__ void ph_norm2_route(const float* x1, const float* norm2_w, const float* router_w, const float* router_b, unsigned char* ws, LAS unsigned char* lds, int bid, int nb) {
    int tidl = threadIdx.x; asm volatile("" : "+v"(tidl));
    const int lane = tidl & 63, wave = tidl >> 6, r16 = lane & 15, kq = lane >> 4;
    const float* mod = (const float*)(ws + WS_MOD);
    bf16* H = (bf16*)(ws + WS_H);
    unsigned* ctl = (unsigned*)(ws + WS_CTL);
    int* selE = (int*)(ws + WS_SELE); float* selW = (float*)(ws + WS_SELW); int* selP = (int*)(ws + WS_SELP);
    constexpr int PITCH = 2052;
    LAS float* hrow = (LAS float*)lds;
    LAS float* part = (LAS float*)lds;
    LAS int* lcnt = (LAS int*)(lds + 16 * PITCH * 4);
    if (threadIdx.x < 128) lcnt[threadIdx.x] = 0;
    __syncthreads();
    const bf16* WH = (const bf16*)(ws + WS_RWH); const bf16* WL = (const bf16*)(ws + WS_RWL);
    f32x4 wn[8];
#pragma unroll
    for (int j = 0; j < 8; ++j) wn[j] = *(const f32x4*)(norm2_w + 4 * lane + 256 * j);
    f32x4 va[2][8];
    if (bid < T / 16) {
#pragma unroll
        for (int rr = 0; rr < 2; ++rr)
#pragma unroll
            for (int j = 0; j < 8; ++j) va[rr][j] = ((const f32x4*)(x1 + (size_t)(bid * 16 + 2 * wave + rr) * D) + lane)[64 * j];
    }
    for (int g = bid; g < T / 16; g += nb) {
        const int r0 = g * 16;
        f32x4 sh[8], sc[8];
        { const int b = r0 / SEQ;
#pragma unroll
          for (int j = 0; j < 8; ++j) { sh[j] = *(const f32x4*)(mod + b * 6 * D + 3 * D + 4 * lane + 256 * j); sc[j] = *(const f32x4*)(mod + b * 6 * D + 4 * D + 4 * lane + 256 * j); } }
        asm volatile("" ::: "memory");
        asm volatile("" : "+v"(sh[0]), "+v"(sh[1]), "+v"(sh[2]), "+v"(sh[3]), "+v"(sh[4]), "+v"(sh[5]), "+v"(sh[6]), "+v"(sh[7]));
        asm volatile("" : "+v"(sc[0]), "+v"(sc[1]), "+v"(sc[2]), "+v"(sc[3]), "+v"(sc[4]), "+v"(sc[5]), "+v"(sc[6]), "+v"(sc[7]));
#pragma unroll
        for (int rr = 0; rr < 2; ++rr) {
            const int rl = 2 * wave + rr, row = r0 + rl; float ss = 0.f;
#pragma unroll
            for (int j = 0; j < 8; ++j) ss += (va[rr][j].x * va[rr][j].x + va[rr][j].y * va[rr][j].y) + (va[rr][j].z * va[rr][j].z + va[rr][j].w * va[rr][j].w);
            const float rstd = rsqrtf(wave_sum(ss) * (1.f / D) + EPS);
#pragma unroll
            for (int j = 0; j < 8; ++j) {
                const int col = 4 * lane + 256 * j;
                const f32x4 y = va[rr][j] * rstd * wn[j] * (sc[j] + 1.0f) + sh[j];
                *(unsigned*)((unsigned char*)H + (size_t)row * D + col) = pk4_fp8(y.x, y.y, y.z, y.w);
                *(LAS f32x4*)(hrow + rl * PITCH + col) = y;
            }
        }
        lds_barrier();
        f32x4 acc[4];
#pragma unroll
        for (int e = 0; e < 4; ++e) acc[e] = (f32x4){0.f, 0.f, 0.f, 0.f};
        const LAS float* ap = hrow + r16 * PITCH + 256 * wave + 8 * kq;
        const size_t bo = ((size_t)wave * 8 * 4 * 64 + lane) * 8;
        bf16x8 bh0[4], bl0[4];
#define RT_LOADB(BH, BL, KS) do { _Pragma("unroll") for (int eb = 0; eb < 4; ++eb) { BH[eb] = *(const bf16x8*)(WH + bo + (size_t)((KS) * 4 + eb) * 512); BL[eb] = *(const bf16x8*)(WL + bo + (size_t)((KS) * 4 + eb) * 512); } } while (0)
#define RT_STEP(BH, BL, KS) do { const f32x4 a0 = *(const LAS f32x4*)(ap + 32 * (KS)), a1 = *(const LAS f32x4*)(ap + 32 * (KS) + 4); \
            u32x4 hw = pg8::pack8(a0, a1); f32x4 h0, h1; pg8::unpack8(hw, h0, h1); const u32x4 lw = pg8::pack8(a0 - h0, a1 - h1); \
            const bf16x8 ah = __builtin_bit_cast(bf16x8, hw), al = __builtin_bit_cast(bf16x8, lw); \
            _Pragma("unroll") for (int eb = 0; eb < 4; ++eb) { acc[eb] = __builtin_amdgcn_mfma_f32_16x16x32_bf16(ah, BH[eb], acc[eb], 0, 0, 0); \
                acc[eb] = __builtin_amdgcn_mfma_f32_16x16x32_bf16(al, BH[eb], acc[eb], 0, 0, 0); acc[eb] = __builtin_amdgcn_mfma_f32_16x16x32_bf16(ah, BL[eb], acc[eb], 0, 0, 0); } } while (0)
#pragma unroll 1
        for (int ks = 0; ks < 8; ++ks) {
            RT_LOADB(bh0, bl0, ks);
            asm volatile("" ::: "memory");
            RT_STEP(bh0, bl0, ks);
        }
#undef RT_LOADB
#undef RT_STEP
        if (g + nb < T / 16) {
#pragma unroll
            for (int rr = 0; rr < 2; ++rr)
#pragma unroll
                for (int j = 0; j < 8; ++j) va[rr][j] = ((const f32x4*)(x1 + (size_t)((g + nb) * 16 + 2 * wave + rr) * D) + lane)[64 * j];
        }
        lds_barrier();
#pragma unroll
        for (int rr = 0; rr < 4; ++rr) *(LAS f32x4*)(part + (wave * 16 + 4 * kq + rr) * 64 + 4 * r16) = (f32x4){acc[0][rr], acc[1][rr], acc[2][rr], acc[3][rr]};
        lds_barrier();
#pragma unroll 1
        for (int rr = 0; rr < 2; ++rr) {
            const int rl = 2 * wave + rr, row = r0 + rl;
            float lg = 0.f;
#pragma unroll
            for (int w8 = 0; w8 < 8; ++w8) lg += part[(w8 * 16 + rl) * 64 + lane];
            if (!(fabsf(lg) < 1e30f)) lg = 0.f;
            const float score = sigmoid_f(lg), biased = score + router_b[lane];
            float m1 = biased;
            m1 = fmaxf(m1, __shfl_xor(m1, 1)); m1 = fmaxf(m1, __shfl_xor(m1, 2)); m1 = fmaxf(m1, __shfl_xor(m1, 4));
            const unsigned long long eq = __ballot(biased == m1);
            const int gbase = lane & ~7;
            const unsigned geq = (unsigned)((eq >> gbase) & 0xffull);
            const int first = gbase + __builtin_ctz(geq | 0x100u);
            float m2 = (lane == first) ? -INFINITY : biased;
            m2 = fmaxf(m2, __shfl_xor(m2, 1)); m2 = fmaxf(m2, __shfl_xor(m2, 2)); m2 = fmaxf(m2, __shfl_xor(m2, 4));
            const float gs = m1 + m2;
            const int gi = lane >> 3; int grank = 0;
#pragma unroll
            for (int gg = 0; gg < 8; ++gg) { const float o = __shfl(gs, gg * 8); grank += (o > gs || (o == gs && gg < gi)) ? 1 : 0; }
            const float masked = (grank < 4) ? biased : -INFINITY;
            int rank = 0;
#pragma unroll 8
            for (int e = 0; e < 64; ++e) { const float o = __shfl(masked, e); rank += (o > masked || (o == masked && e < lane)) ? 1 : 0; }
            const bool sel = rank < TOPK;
            const float ssum = wave_sum(sel ? score : 0.f);
            if (sel) {
                const int pos = __hip_atomic_fetch_add(&lcnt[lane], 1, __ATOMIC_RELAXED, __HIP_MEMORY_SCOPE_WORKGROUP);
                selE[row * 8 + rank] = lane; selW[row * 8 + rank] = score / ssum * ROUTED_SCALE; selP[row * 8 + rank] = pos;
            }
        }
        lds_barrier();
    }
    asm volatile("s_waitcnt vmcnt(0)" ::: "memory");
    __syncthreads();
    if (threadIdx.x < 64) lcnt[64 + threadIdx.x] = (int)atomicAdd(&ctl[CW_CNT + 64 * threadIdx.x], (unsigned)lcnt[threadIdx.x]);
    __syncthreads();
    for (int g = bid; g < T / 16; g += nb)
        for (int i = threadIdx.x; i < 128; i += NTHREADS) { const int idx = g * 128 + i, e = selE[idx], pos = selP[idx] + lcnt[64 + e]; selP[idx] = pos;
            ((int*)(ws + WS_LTOK))[(size_t)e * T + pos] = idx >> 3; ((float*)(ws + WS_LW))[(size_t)e * T + pos] = selW[idx]; }
}
__device__ __forceinline__ void ph_scatter(const Params& p, LAS unsigned char* lds, int bid, int nb) {
    unsigned char* ws = p.ws; unsigned* ctl = (unsigned*)(ws + WS_CTL);
    const int* selE = (const int*)(ws + WS_SELE); const float* selW = (const float*)(ws + WS_SELW); const int* selP = (const int*)(ws + WS_SELP);
    int* prow = (int*)(ws + WS_PROW); int* rtok = (int*)(ws + WS_RTOK); float* rw = (float*)(ws + WS_RW);
    LAS int* sbase = (LAS int*)lds; LAS int* scnt = (LAS int*)(lds + 512);
    if (threadIdx.x < 64) {
        const int e = threadIdx.x, c = (int)ctl[CW_CNT + 64 * e], pad = (c + 255) & ~255;
        int incl = pad;
#pragma unroll
        for (int o = 1; o < 64; o <<= 1) { const int v = __shfl_up(incl, o); if (e >= o) incl += v; }
        sbase[e] = incl - pad; scnt[e] = c; if (e == 63) sbase[64] = incl;
        if (bid == 0) { ctl[CW_BASE + e] = (unsigned)(incl - pad); if (e == 63) ctl[CW_BASE + 64] = (unsigned)incl; }
    }
    __syncthreads();
    for (int i = bid * NTHREADS + threadIdx.x; i < T * TOPK; i += nb * NTHREADS) {
        const int e = selE[i], r = sbase[e] + selP[i];
        prow[i] = r; rtok[r] = i >> 3; rw[r] = selW[i];
    }
    for (int e = bid; e < NE; e += nb) { const int lo = sbase[e] + scnt[e], hi = sbase[e + 1];
        for (int r = lo + threadIdx.x; r < hi; r += NTHREADS) { rtok[r] = 0; rw[r] = 0.f; } }
}
__device__ __forceinline__ int expert_of_row(const unsigned* ctl, int row) { int e = 0; while (e < NE - 1 && (int)ctl[CW_BASE + e + 1] <= row) ++e; return e; }
__device__ __forceinline__ void ph_moe_gu(const Params& p, LAS unsigned char* lds, int bid, int nb) {
    unsigned char* ws = p.ws; const unsigned* ctl = (const unsigned*)(ws + WS_CTL);
    const int rows = (int)ctl[CW_BASE + NE], tm = rows / 128, tn = 1024 / 256;
    EpiGU E{(bf16*)(ws + WS_ACT)};
    for (int t = bid; t < tm * tn; t += nb) { const int pm = t / tn, pn = t % tn; const int e = expert_of_row(ctl, pm * 128);
        GemmS g{(const bf16*)(ws + WS_H), D, (const int*)(ws + WS_RTOK), (const bf16*)(ws + WS_WGU) + (size_t)e * 1024 * D, D, D};
        gemm_tile_simple(g, pm * 128, pn * 256, lds, E); }
    GemmS gs{(const bf16*)(ws + WS_H), D, nullptr, (const bf16*)(ws + WS_WSGU), D, D};
    EpiGU Es{(bf16*)(ws + WS_ACTS)};
    gemm_simple(gs, T, 1024, lds, Es, bid, nb);
}
__device__ __forceinline__ void ph_moe_down(const Params& p, LAS unsigned char* lds, int bid, int nb) {
    unsigned char* ws = p.ws; const unsigned* ctl = (const unsigned*)(ws + WS_CTL);
    const int rows = (int)ctl[CW_BASE + NE], tm = rows / 128, tn = 2048 / 256;
    EpiDown E{(bf16*)(ws + WS_Y), (const float*)(ws + WS_RW)};
    for (int t = bid; t < tm * tn; t += nb) { const int pm = t / tn, pn = t % tn; const int e = expert_of_row(ctl, pm * 128);
        GemmS g{(const bf16*)(ws + WS_ACT), DEXP, nullptr, (const bf16*)(ws + WS_WD) + (size_t)e * D * DEXP, DEXP, DEXP};
        gemm_tile_simple(g, pm * 128, pn * 256, lds, E); }
    GemmS gs{(const bf16*)(ws + WS_ACTS), DSH, nullptr, (const bf16*)(ws + WS_WSD), DSH, DSH};
    EpiDownS Es{p.out, (const float*)(ws + WS_MOD)};
    gemm_simple(gs, T, 2048, lds, Es, bid, nb);
}
typedef float f32x2c __attribute__((ext_vector_type(2)));
__device__ __attribute__((noinline)) void ph_combine(float* pout_, const float* final_w_, unsigned char* ws_, LAS unsigned char* lds, int bid, int nb) {
    float GAS* pout = (float GAS*)pout_; const float GAS* final_w = (const float GAS*)final_w_; unsigned char GAS* ws = (unsigned char GAS*)ws_;
    const int lane = threadIdx.x & 63, wave = threadIdx.x >> 6; const float GAS* mod = (const float GAS*)(ws + WS_MOD); const unsigned char GAS* Y = ws + WS_Y;
    const int GAS* selE = (const int GAS*)(ws + WS_SELE); const int GAS* selP = (const int GAS*)(ws + WS_SELP);
    *(LAS f32x4*)(lds + 16 * threadIdx.x) = *(const f32x4 GAS*)(final_w + 4 * threadIdx.x);
    (void)pg8::moe_base_tables((const unsigned*)(ws_ + WS_CTL), lds); const LAS int* ebase = (const LAS int*)(lds + pg8::MOE_LDS_BASE);
    for (int row = bid * 8 + wave; row < T; row += nb * 8) {
        const int b = row / SEQ;
        int pr[8], se[8], sp[8];
#pragma unroll
        for (int k = 0; k < 8; ++k) { se[k] = selE[row * 8 + k]; sp[k] = selP[row * 8 + k]; }
        asm volatile("" ::: "memory");
#pragma unroll
        for (int k = 0; k < 8; ++k) pr[k] = __builtin_amdgcn_readfirstlane(ebase[se[k]] + sp[k]);
        asm volatile("" ::: "memory");
        f32x4 v[2][4]; float s = 0.f;
#pragma unroll
        for (int j = 0; j < 2; ++j) {
            const int col = 16 * lane + 1024 * j;
            u32x4 y[9]; f32x4 xv[4], gv[4];
#pragma unroll
            for (int k = 0; k < 8; ++k) y[k] = __builtin_nontemporal_load((const u32x4 GAS*)(Y + (size_t)pr[k] * 2048 + col));
            y[8] = __builtin_nontemporal_load((const u32x4 GAS*)(Y + (size_t)(CAP + row) * 2048 + col));
            const float GAS* xr = pout + (size_t)row * D + col; const float GAS* gr = mod + b * 6 * D + 5 * D + col;
#pragma unroll
            for (int d = 0; d < 4; ++d) { xv[d] = *(const f32x4 GAS*)(xr + 4 * d); gv[d] = *(const f32x4 GAS*)(gr + 4 * d); }
            asm volatile("" ::: "memory");
            asm volatile("" : "+v"(y[0]), "+v"(y[1]), "+v"(y[2]), "+v"(y[3]), "+v"(y[4]), "+v"(y[5]), "+v"(y[6]), "+v"(y[7]), "+v"(y[8]));
            asm volatile("" : "+v"(xv[0]), "+v"(xv[1]), "+v"(xv[2]), "+v"(xv[3]), "+v"(gv[0]), "+v"(gv[1]), "+v"(gv[2]), "+v"(gv[3]));
            float a[16];
#pragma unroll
            for (int i = 0; i < 16; ++i) a[i] = 0.f;
#pragma unroll
            for (int k = 0; k < 9; ++k) { const unsigned w[4] = {y[k].x, y[k].y, y[k].z, y[k].w};
#pragma unroll
                for (int d = 0; d < 4; ++d) { const f32x2c lo = __builtin_amdgcn_cvt_pk_f32_fp8((int)w[d], false), hi = __builtin_amdgcn_cvt_pk_f32_fp8((int)w[d], true);
                    a[4 * d] += lo[0]; a[4 * d + 1] += lo[1]; a[4 * d + 2] += hi[0]; a[4 * d + 3] += hi[1]; } }
#pragma unroll
            for (int d = 0; d < 4; ++d) { const f32x4 av = (f32x4){a[4 * d], a[4 * d + 1], a[4 * d + 2], a[4 * d + 3]} * 0.0625f;
                v[j][d] = xv[d] + gv[d] * av;
                s += (v[j][d].x * v[j][d].x + v[j][d].y * v[j][d].y) + (v[j][d].z * v[j][d].z + v[j][d].w * v[j][d].w); }
        }
        const float rstd = rsqrtf(wave_sum(s) * (1.f / D) + EPS);
#pragma unroll
        for (int j = 0; j < 2; ++j) { const int col = 16 * lane + 1024 * j; float GAS* o = pout + (size_t)row * D + col;
#pragma unroll
            for (int d = 0; d < 4; ++d) *(f32x4 GAS*)(o + 4 * d) = v[j][d] * rstd * *(const LAS f32x4*)(lds + 4 * (col + 4 * d)); }
    }
}

#define XB_TMO      128
#define XB_XCNT(j)  (256  + 64 * (j))
#define XB_XSUB(j)  (1280 + 64 * (j))
#define XB_XGEN(j)  (2304 + 64 * (j))
#define XB_TOP      3328
#define XB_TOPGEN   3392
#define XCD_BAR_WORDS 3456
#define XB_SPIN_CAP (1u << 18)
__device__ __forceinline__ unsigned xb_ld(unsigned* p)              { return __hip_atomic_load(p, __ATOMIC_RELAXED, __HIP_MEMORY_SCOPE_AGENT); }
__device__ __forceinline__ unsigned xb_add(unsigned* p, unsigned v) { return __hip_atomic_fetch_add(p, v, __ATOMIC_RELAXED, __HIP_MEMORY_SCOPE_AGENT); }
__device__ __forceinline__ unsigned xb_xcc_id() { return (unsigned)__builtin_amdgcn_s_getreg((3 << 11) | 20) & 0xFu; }
#define XB_SPIN(cond, bar) do { unsigned _sp = 0; while (cond) { __builtin_amdgcn_s_sleep(1); \
    if ((++_sp & 255u) == 0u) { if (xb_ld(&(bar)[XB_TMO])) break; if (_sp > XB_SPIN_CAP) { atomicAdd(&(bar)[XB_TMO], 1u); break; } } } } while (0)
struct XcdBarrier { unsigned* bar; unsigned x; volatile LAS unsigned* st; };
__device__ __forceinline__ XcdBarrier xcd_barrier_post(unsigned* bar, volatile LAS unsigned* st) {
    XcdBarrier b; b.bar = bar; b.x = xb_xcc_id(); b.st = st;
    if (threadIdx.x == 0) (void)xb_add(&bar[XB_XCNT(b.x)], 1u);
    return b;
}
__device__ __forceinline__ void xcd_barrier_complete(unsigned* bar, unsigned x, unsigned& nloc, unsigned& nx) {
    const unsigned G = gridDim.x * gridDim.y * gridDim.z;
    unsigned sum, cnt, mine, sp = 0u;
    for (;;) {
        sum = 0u; cnt = 0u; mine = 0u;
#pragma unroll
        for (unsigned j = 0; j < 16; ++j) { const unsigned c = xb_ld(&bar[XB_XCNT(j)]); sum += c; cnt += (c > 0u) ? 1u : 0u; mine = (j == x) ? c : mine; }
        if (sum == G) break;
        __builtin_amdgcn_s_sleep(1);
        if ((++sp & 255u) == 0u) { if (xb_ld(&bar[XB_TMO])) break; if (sp > XB_SPIN_CAP) { atomicAdd(&bar[XB_TMO], 1u); break; } }
    }
    nloc = mine > 0u ? mine : 1u; nx = cnt > 0u ? cnt : 1u;
}
__device__ __forceinline__ void xcd_barrier(const XcdBarrier& b) {
    asm volatile("s_waitcnt vmcnt(0)" ::: "memory");
    __syncthreads();
    if (threadIdx.x == 0) {
        unsigned* bar = b.bar;
        __builtin_amdgcn_s_waitcnt(0);
        unsigned nloc = b.st[0], nx = b.st[1];
        if (nloc == 0u) { xcd_barrier_complete(bar, b.x, nloc, nx); b.st[0] = nloc; b.st[1] = nx; }
        const unsigned old = xb_add(&bar[XB_XSUB(b.x)], 1u);
        const unsigned gen = old / nloc;
        if (old + 1u == (gen + 1u) * nloc) {
            __builtin_amdgcn_fence(__ATOMIC_RELEASE, "agent");
            asm volatile("s_waitcnt vmcnt(0)" ::: "memory");
            const unsigned og = xb_add(&bar[XB_TOP], 1u);
            const unsigned tg = og / nx;
            if (og + 1u == (tg + 1u) * nx) xb_add(&bar[XB_TOPGEN], 1u);
            else XB_SPIN(xb_ld(&bar[XB_TOPGEN]) == tg, bar);
            __builtin_amdgcn_fence(__ATOMIC_ACQUIRE, "agent");
            xb_add(&bar[XB_XGEN(b.x)], 1u);
            asm volatile("s_waitcnt vmcnt(0)" ::: "memory");
        } else {
            XB_SPIN(xb_ld(&bar[XB_XGEN(b.x)]) == gen, bar);
            __builtin_amdgcn_fence(__ATOMIC_ACQUIRE, "agent");
            asm volatile("s_waitcnt vmcnt(0)" ::: "memory");
        }
    }
    __syncthreads();
}
constexpr int CW_BAR = 4096;

constexpr int NPH = 15;
__global__ void __launch_bounds__(NTHREADS, 2) mk(Params p) {
    extern __shared__ __attribute__((aligned(16))) unsigned char lds_raw[];
    LAS unsigned char* lds = (LAS unsigned char*)lds_raw;
    const int bid = blockIdx.x, nb = gridDim.x;
    volatile LAS unsigned* xbw = (volatile LAS unsigned*)(lds + LDS_BYTES - 16);
    if (threadIdx.x == 0) { xbw[0] = 0u; xbw[1] = 0u; xbw[2] = 0u; xbw[3] = 0u; }
    __syncthreads();
    XcdBarrier bar = xcd_barrier_post((unsigned*)(p.ws + WS_CTL) + CW_BAR, xbw);
#ifndef ONLYMASK
#define ONLYMASK 0x7fff
#endif
#define IN(k) ((ONLYMASK >> (k)) & 1)
#define LOADP() do {} while (0)
#define SEAM(k) do { if (IN(k) && IN((k) + 1)) xcd_barrier(bar); } while (0)
    if (IN(0)) { LOADP(); ph_adaln(p, lds, bid, nb); }
    if (IN(1)) { LOADP(); ph_convert(p, lds, xbw + 2); }
    SEAM(1);
    if (IN(2)) { LOADP(); ph_norm1(p, bid, nb); }
    SEAM(2);
    if (IN(3)) { LOADP(); unsigned char* ws = p.ws;
        pg8::DenseSched S{(const bf16*)(ws + WS_H), 2 * D, (const bf16*)(ws + WS_WIN), 2 * D, 2 * D, T / 256, 7168 / 256, nb, bid};
        pg8::EpiInF E{ws, 0};
        typedef pg8::DenseSched8<127, 121> SchedG8;
        SchedG8 S8{{(const bf16*)(ws + WS_H8A), D, (const bf16*)(ws + WS_WIN8), D, D, T / 256, 4096 / 256, nb, bid}};
        pg8::EpiInF E8{ws, 28};
        const int grp = (bid >> 3) & 3;
        for (int part = 0; part < 2; ++part) {
            S8.i0 = part ? grp : 0; S8.i1 = part ? (1 << 30) : grp;
            pg8::gemm_phase<pg8::EpiInF, SchedG8, true, false, true>(lds, S8, E8, -1);
            if (part == 0) pg8::gemm_phase<pg8::EpiInF, pg8::DenseSched, true, false>(lds, S, E, -1);
        }
    }
    SEAM(3);
    if (IN(4)) { LOADP(); ph_kv_conv(p, lds, bid, nb); }
    SEAM(4);
    if (IN(5)) { LOADP(); ph_ret_out(p, lds, bid, nb); }
    SEAM(5);
    if (IN(6)) { LOADP(); unsigned char* ws = p.ws;
        pg8::DenseSched S{(const bf16*)(ws + WS_ACAT), 4096, (const bf16*)(ws + WS_WRC), 4096, 4096, T / 256, D / 256, nb, bid};
        pg8::EpiMergeF E{(bf16*)(ws + WS_MERGED), (const bf16*)(ws + WS_GR), (const bf16*)(ws + WS_GC)};
        pg8::gemm_phase<pg8::EpiMergeF, pg8::DenseSched, true, true>(lds, S, E, 16);
    }
    SEAM(6);
    if (IN(8)) { LOADP(); unsigned char* ws = p.ws;
        pg8::DenseSched S{(const bf16*)(ws + WS_MERGED), 4096, (const bf16*)(ws + WS_WOUT), 4096, 4096, T / 256, D / 256, nb, bid};
        pg8::EpiRes1F E{p.x, p.out, (const float*)(ws + WS_MOD)};
        pg8::gemm_phase<pg8::EpiRes1F, pg8::DenseSched, true, false>(lds, S, E, -1);
    }
    SEAM(8);
    if (IN(9)) { LOADP(); ph_norm2_route(p.out, p.norm2_w, p.router_w, p.router_b, p.ws, lds, bid, nb); }
    SEAM(9);
    if (IN(12)) { LOADP(); unsigned char* ws = p.ws;
        const unsigned* ctl = (const unsigned*)(ws + WS_CTL);
        const int total_rt = pg8::moe_base_tables(ctl, lds) / 256;
        typedef pg8::MoeSched<true, true, 127, 121> SchedGU;
        SchedGU S{(const bf16*)(ws + WS_H), D, D, D, total_rt + T / 256, 4, nb, bid, total_rt, (const char*)(ws + WS_WGU), (size_t)1024 * D, (const char*)(ws + WS_WSGU), lds};
        S.setup((const int*)(ws + WS_LTOK));
        pg8::EpiGUF E{ws + WS_ACT};
        pg8::gemm_phase<pg8::EpiGUF, SchedGU, true, false, true>(lds, S, E, -1);
        conv_down_queue(p, lds, xbw + 2);
    }
    SEAM(12);
    if (IN(13)) { LOADP(); unsigned char* ws = p.ws;
        const unsigned* ctl = (const unsigned*)(ws + WS_CTL);
        const int total_rt = pg8::moe_base_tables(ctl, lds) / 256;
        typedef pg8::MoeSched<false, true, 125, 122> SchedDn;
        SchedDn S{(const bf16*)(ws + WS_ACT), DEXP, DEXP, DEXP, total_rt + T / 256, 8, nb, bid, total_rt, (const char*)(ws + WS_WD), (size_t)D * DEXP, (const char*)(ws + WS_WSD), lds};
        S.setup(nullptr);
        pg8::EpiDownF E{ws + WS_Y, (const float*)(ws + WS_LW), lds};
        pg8::gemm_phase<pg8::EpiDownF, SchedDn, true, false, true>(lds, S, E, -1);
    }
    SEAM(13);
    if (IN(14)) { LOADP(); ph_combine(p.out, p.final_w, p.ws, lds, bid, nb); }
#undef IN
}

extern "C" void kernel_launch(void* const* d_in, const int* in_sizes, int n_in, void* d_out, int out_size, void* d_ws, size_t ws_size, hipStream_t stream) {
    static int grid = 0;
    if (grid == 0) {
        if (n_in != 23 || out_size != T * D || ws_size < WS_END) { fprintf(stderr, "kernel_launch: unexpected shapes (n_in %d out %d ws %zu need %zu)\n", n_in, out_size, ws_size, (size_t)WS_END); grid = -1; return; }
        if (hipFuncSetAttribute((const void*)mk, hipFuncAttributeMaxDynamicSharedMemorySize, LDS_BYTES) != hipSuccess) { fprintf(stderr, "hipFuncSetAttribute failed\n"); grid = -1; return; }
        int dev = 0, cus = 0; hipGetDevice(&dev); hipDeviceGetAttribute(&cus, hipDeviceAttributeMultiprocessorCount, dev);
        grid = cus > 0 ? cus : 256;
    }
    if (grid < 0) return;
    hipMemsetAsync((char*)d_ws + WS_CTL, 0, CTL_ZERO_BYTES, stream);
    Params p{};
    const float** pp = (const float**)&p;
    for (int i = 0; i < 23; ++i) pp[i] = (const float*)d_in[i];
    p.out = (float*)d_out; p.ws = (unsigned char*)d_ws;
    hipLaunchKernelGGL(mk, dim3(grid), dim3(NTHREADS), LDS_BYTES, stream, p);
}
```

```cpp
#include <hip/hip_runtime.h>
#include <cstdio>
#include <cstdint>

typedef unsigned short bf16;
typedef short bf16x8 __attribute__((ext_vector_type(8)));
typedef float f32x4 __attribute__((ext_vector_type(4)));
typedef unsigned u32x4 __attribute__((ext_vector_type(4)));
#define LAS __attribute__((address_space(3)))
#define GAS __attribute__((address_space(1)))

constexpr int BATCH = 8, SEQ = 2048, T = BATCH * SEQ, D = 2048, DRET = 1024, NH = 8, HD = 128, CH = 128, NCH = 16;
constexpr int DCONV = 1024, DIN = 11264, NE = 64, TOPK = 8, DEXP = 512, DSH = 512;
constexpr float EPS = 1e-6f, ROUTED_SCALE = 2.5f;
constexpr int CAP = T * TOPK + NE * 256;
constexpr int NTHREADS = 512;

constexpr size_t MiB = 1u << 20;
constexpr size_t WS_CTL = 0, CTL_ZERO_BYTES = 1 * MiB;
constexpr size_t WS_MOD = 1 * MiB;
constexpr size_t WS_ROT = 2 * MiB;
constexpr size_t WS_SELE = 3 * MiB;
constexpr size_t WS_SELW = WS_SELE + 512 * 1024;
constexpr size_t WS_SELP = 4 * MiB;
constexpr size_t WS_PROW = WS_SELP + 512 * 1024;
constexpr size_t WS_RTOK = 5 * MiB;
constexpr size_t WS_RWH = 5 * MiB, WS_RWL = WS_RWH + 256 * 1024;
constexpr size_t WS_RW = 6 * MiB;
constexpr size_t WS_WIN = 8 * MiB;
constexpr size_t WS_WRC = WS_WIN + 44 * MiB;
constexpr size_t WS_WOUT = WS_WRC + 8 * MiB;
constexpr size_t WS_WSGU = WS_WOUT + 8 * MiB;
constexpr size_t WS_WSD = WS_WSGU + 4 * MiB;
constexpr size_t WS_WD = 74 * MiB;
constexpr size_t WS_WGU = WS_WD + 128 * MiB;
constexpr size_t WS_ACTR = WS_WGU + 256 * MiB;
constexpr size_t WS_Q = WS_ACTR, WS_K = WS_Q + 32 * MiB, WS_V = WS_K + 32 * MiB, WS_G = WS_V + 32 * MiB, WS_CB = WS_G + 32 * MiB, WS_UP = WS_CB + 32 * MiB;
constexpr size_t WS_GR = WS_UP + 32 * MiB, WS_GC = WS_GR + 64 * MiB;
constexpr size_t WS_KVF = WS_GC + 64 * MiB, WS_KVB = WS_KVF + 32 * MiB;
constexpr size_t WS_ACAT = WS_KVB + 32 * MiB, WS_MERGED = WS_ACAT + 64 * MiB, WS_H = WS_MERGED + 64 * MiB;
constexpr size_t WS_H8A = WS_H + 64 * MiB;
constexpr size_t WS_WIN8 = WS_H8A + 32 * MiB;
constexpr size_t WS_LTOK = WS_WIN8 + 8 * MiB;
constexpr size_t WS_LW = WS_LTOK + 4 * MiB;
constexpr size_t WS_END = WS_LW + 4 * MiB;
constexpr size_t WS_Y = WS_WGU;
constexpr size_t WS_ACT = WS_ACTR + 320 * MiB;
constexpr size_t WS_ACTS = WS_ACT + 144 * MiB;
static_assert(WS_ACTS + 16 * MiB <= WS_H, "moe overlay");
static_assert((size_t)CAP * 2048 * 2 <= 576 * MiB && (size_t)CAP * 512 * 2 <= 144 * MiB, "cap");
constexpr int CW_CNT = 16384;
constexpr int CW_BASE = 1280;
constexpr int CW_Q = 2048;
constexpr int LDS_BYTES = 147456;

struct Params {
    const float *x, *c, *w_ada, *b_ada, *norm1_w, *w_in, *dec_f, *dec_b, *ret_norm_w, *w_ret_o, *conv_w, *w_conv_o, *w_out, *norm2_w,
        *router_w, *router_b, *w_gate, *w_up, *w_down, *ws_gate, *ws_up, *ws_down, *final_w;
    float* out; unsigned char* ws;
};

__device__ __forceinline__ float bf2f(bf16 v) { return __uint_as_float((unsigned)v << 16); }
__device__ __forceinline__ bf16 f2bf(float f) { unsigned u = __float_as_uint(f); return (bf16)((u + 0x7fffu + ((u >> 16) & 1u)) >> 16); }
__device__ __forceinline__ float sigmoid_f(float v) { return __builtin_amdgcn_rcpf(1.f + __builtin_amdgcn_exp2f(-1.4426950408889634f * v)); }
__device__ __forceinline__ float silu_f(float v) { return v * sigmoid_f(v); }
__device__ __forceinline__ unsigned pk4_fp8(float a, float b, float c, float d) {
    a = __builtin_amdgcn_fmed3f(a, -440.f, 440.f); b = __builtin_amdgcn_fmed3f(b, -440.f, 440.f); c = __builtin_amdgcn_fmed3f(c, -440.f, 440.f); d = __builtin_amdgcn_fmed3f(d, -440.f, 440.f);
    int p = 0; p = __builtin_amdgcn_cvt_pk_fp8_f32(a, b, p, false); p = __builtin_amdgcn_cvt_pk_fp8_f32(c, d, p, true); return (unsigned)p; }
__device__ __forceinline__ void lds_barrier() { asm volatile("s_waitcnt lgkmcnt(0)" ::: "memory"); __builtin_amdgcn_s_barrier(); asm volatile("" ::: "memory"); }
__device__ __forceinline__ float wave_sum(float v) {
#pragma unroll
    for (int o = 1; o < 64; o <<= 1) v += __shfl_xor(v, o);
    return v;
}
__device__ __forceinline__ float block_sum(float v, LAS float* red) {
    v = wave_sum(v);
    __syncthreads();
    if ((threadIdx.x & 63) == 0) red[threadIdx.x >> 6] = v;
    __syncthreads();
    float s = 0.f;
#pragma unroll
    for (int i = 0; i < NTHREADS / 64; ++i) s += red[i];
    return s;
}

__device__ __forceinline__ void ph_adaln(const Params& p, LAS unsigned char* lds, int bid, int nb) {
    LAS float* sc = (LAS float*)lds;
    LAS float* red = (LAS float*)(lds + 65536);
    {
        f32x4 cv[8];
#pragma unroll
        for (int i = 0; i < 8; ++i) cv[i] = *(const f32x4*)(p.c + 4 * (threadIdx.x + NTHREADS * i));
#pragma unroll
        for (int i = 0; i < 8; ++i) { f32x4 o; o.x = silu_f(cv[i].x); o.y = silu_f(cv[i].y); o.z = silu_f(cv[i].z); o.w = silu_f(cv[i].w); *(LAS f32x4*)(sc + 4 * (threadIdx.x + NTHREADS * i)) = o; }
    }
    __syncthreads();
    float* mod = (float*)(p.ws + WS_MOD);
    const int c = threadIdx.x & 31, s = threadIdx.x >> 5;
    for (int item = bid; item < 6 * D / 32; item += nb) {
        const int col = item * 32 + c;
        float acc[8];
#pragma unroll
        for (int b = 0; b < 8; ++b) acc[b] = 0.f;
        for (int k0 = s * 128; k0 < s * 128 + 128; k0 += 32) {
            float w[32];
#pragma unroll
            for (int i = 0; i < 32; ++i) w[i] = __builtin_nontemporal_load(p.w_ada + (size_t)(k0 + i) * (6 * D) + col);
            asm volatile("" ::: "memory");
#pragma unroll
            for (int i = 0; i < 32; i += 8) asm volatile("" : "+v"(w[i]), "+v"(w[i + 1]), "+v"(w[i + 2]), "+v"(w[i + 3]), "+v"(w[i + 4]), "+v"(w[i + 5]), "+v"(w[i + 6]), "+v"(w[i + 7]));
#pragma unroll
            for (int i = 0; i < 32; i += 4)
#pragma unroll
                for (int b = 0; b < 8; ++b) { const f32x4 s4 = *(const LAS f32x4*)(sc + b * D + k0 + i); acc[b] += (s4.x * w[i] + s4.y * w[i + 1]) + (s4.z * w[i + 2] + s4.w * w[i + 3]); }
        }
#pragma unroll
        for (int b = 0; b < 8; ++b) red[(s * 8 + b) * 32 + c] = acc[b];
        __syncthreads();
        if (threadIdx.x < 256) {
            const int b = threadIdx.x >> 5; float t = 0.f;
#pragma unroll
            for (int ss = 0; ss < 16; ++ss) t += red[(ss * 8 + b) * 32 + c];
            mod[b * (6 * D) + col] = t + p.b_ada[col];
        }
        __syncthreads();
    }
    float2* rot = (float2*)(p.ws + WS_ROT);
    for (int i = bid * NTHREADS + threadIdx.x; i < SEQ * 64; i += nb * NTHREADS) {
        const int pos = i >> 6, f = i & 63;
        double inv = 1.0; const double rr = 0.86596432336006535;
        for (int t = 0; t < f; ++t) inv *= rr;
        const double ang = (double)pos * inv;
        const double q = __builtin_rint(ang * 0.63661977236758134308);
        const double r = __builtin_fma(-q, 1.57079632679489661923, ang), r2 = r * r;
        const double sn = r * (1.0 + r2 * (-1.0 / 6 + r2 * (1.0 / 120 + r2 * (-1.0 / 5040 + r2 * (1.0 / 362880 + r2 * (-1.0 / 39916800))))));
        const double cs = 1.0 + r2 * (-0.5 + r2 * (1.0 / 24 + r2 * (-1.0 / 720 + r2 * (1.0 / 40320 + r2 * (-1.0 / 3628800 + r2 * (1.0 / 479001600))))));
        const int qi = ((int)q) & 3;
        const double c2 = (qi == 0) ? cs : (qi == 1) ? -sn : (qi == 2) ? -cs : sn;
        const double s2 = (qi == 0) ? sn : (qi == 1) ? cs : (qi == 2) ? -sn : -cs;
        rot[i] = make_float2((float)c2, (float)s2);
    }
}

__device__ __forceinline__ int conv_dstrow(int kind, int c) {
    if (kind == 1) {
        if (c < 2048) { const int hb = c & ~127, j = c & 127; return hb + 2 * (j & 63) + (j >> 6); }
        if (c >= 5120 && c < 6144) { const int l = c - 5120; return 5120 + (l >> 7) * 256 + (l & 127); }
        if (c >= 6144 && c < 7168) { const int l = c - 6144; return 5120 + (l >> 7) * 256 + 128 + (l & 127); }
        return c;
    }
    if (kind == 2) return (c >> 7) * 256 + (c & 127);
    if (kind == 3) return (c >> 7) * 256 + 128 + (c & 127);
    return c;
}
__device__ __forceinline__ void conv_item(const float* src, int ld, bf16* dst, int dstLd, int koff, int kind, int n0, int k0, LAS unsigned char* img, int lane) {
    const int ng = lane >> 2, kg = lane & 3;
    const float scale = (kind == 1 && n0 >= 1024 && n0 < 2048) ? 0.08838834764831845f : 1.0f;
#pragma unroll
    for (int g = 0; g < 4; ++g) {
        f32x4 v[4];
#pragma unroll
        for (int i = 0; i < 4; ++i) v[i] = __builtin_nontemporal_load((const f32x4*)(src + (size_t)(k0 + 16 * g + 4 * kg + i) * ld + n0 + 4 * ng));
#pragma unroll
        for (int j = 0; j < 4; ++j) {
            const unsigned lo = (unsigned)f2bf(v[0][j] * scale) | ((unsigned)f2bf(v[1][j] * scale) << 16), hi = (unsigned)f2bf(v[2][j] * scale) | ((unsigned)f2bf(v[3][j] * scale) << 16);
            *(LAS unsigned long long*)(img + (4 * ng + j) * 144 + (16 * g + 4 * kg) * 2) = (unsigned long long)lo | ((unsigned long long)hi << 32);
        }
    }
    asm volatile("s_waitcnt lgkmcnt(0)" ::: "memory");
#pragma unroll
    for (int r = 0; r < 8; ++r) {
        const int n = 8 * r + (lane >> 3), kc = lane & 7;
        const u32x4 w = *(const LAS u32x4*)(img + n * 144 + kc * 16);
        *(u32x4*)(dst + (size_t)conv_dstrow(kind, n0 + n) * dstLd + koff + k0 + kc * 8) = w;
    }
    asm volatile("s_waitcnt lgkmcnt(0)" ::: "memory");
}
__device__ __forceinline__ void conv_item8(const float* src, int ld, unsigned char* dst, int dstLd, int kind, int n0, int k0, float scale, LAS unsigned char* img, int lane) {
    const int ng = lane >> 2, kg = lane & 3;
#pragma unroll
    for (int g = 0; g < 4; ++g) {
        f32x4 v[4];
#pragma unroll
        for (int i = 0; i < 4; ++i) v[i] = __builtin_nontemporal_load((const f32x4*)(src + (size_t)(k0 + 16 * g + 4 * kg + i) * ld + n0 + 4 * ng));
#pragma unroll
        for (int j = 0; j < 4; ++j) *(LAS unsigned*)(img + (4 * ng + j) * 80 + 16 * g + 4 * kg) = pk4_fp8(v[0][j] * scale, v[1][j] * scale, v[2][j] * scale, v[3][j] * scale);
    }
    asm volatile("s_waitcnt lgkmcnt(0)" ::: "memory");
#pragma unroll
    for (int r = 0; r < 4; ++r) {
        const int n = 16 * r + (lane >> 2), kc = lane & 3;
        const u32x4 w = *(const LAS u32x4*)(img + n * 80 + kc * 16);
        *(u32x4*)(dst + (size_t)conv_dstrow(kind, n0 + n) * dstLd + k0 + kc * 16) = w;
    }
    asm volatile("s_waitcnt lgkmcnt(0)" ::: "memory");
}
constexpr int CJ_WORDS = 16, CJ_LDS = 8 * 9216;
__device__ __forceinline__ void conv_job_add(LAS unsigned* tab, int& nj, int& nbat, const float* src, int ld, int K, void* dst, int dstLd, int koff, int N, int kind, int fp8, float scale, int nbatch, unsigned srcStride, unsigned dstStride) {
    LAS unsigned* t = tab + nj * CJ_WORDS; const int tn = N / 64, per = tn * (K / 64);
    t[0] = (unsigned)(size_t)src; t[1] = (unsigned)((size_t)src >> 32); t[2] = (unsigned)(size_t)dst; t[3] = (unsigned)((size_t)dst >> 32);
    t[4] = ld; t[5] = dstLd; t[6] = koff; t[7] = tn; t[8] = per; t[9] = kind; t[10] = fp8; t[11] = __float_as_uint(scale); t[12] = srcStride; t[13] = dstStride; t[14] = nbat;
    nbat += per * nbatch / 8; ++nj;
}
__device__ __forceinline__ void ph_convert(const Params& p, LAS unsigned char* lds, volatile LAS unsigned* shw) {
    int tidl = threadIdx.x; asm volatile("" : "+v"(tidl));
    const int lane = tidl & 63, wave = tidl >> 6;
    LAS unsigned char* img = lds + wave * 9216;
    LAS unsigned* tab = (LAS unsigned*)(lds + CJ_LDS);
    unsigned char* ws = p.ws;
    constexpr float SC_GU = 64.f, SC_DN = 32.f;
    if (threadIdx.x == 0) {
        int nj = 0, nbat = 0;
        conv_job_add(tab, nj, nbat, p.w_in, DIN, D, ws + WS_WIN, D, 0, 7168, 1, 0, 1.f, 1, 0, 0);
        conv_job_add(tab, nj, nbat, p.w_in + 7168, DIN, D, ws + WS_WIN8, D, 0, 4096, 0, 1, 64.f, 1, 0, 0);
        conv_job_add(tab, nj, nbat, p.w_ret_o, D, DRET, ws + WS_WRC, 2048, 0, D, 0, 0, 1.f, 1, 0, 0);
        conv_job_add(tab, nj, nbat, p.w_conv_o, D, DCONV, ws + WS_WRC, 2048, 1024, D, 0, 0, 1.f, 1, 0, 0);
        conv_job_add(tab, nj, nbat, p.w_out, D, D, ws + WS_WOUT, D, 0, D, 0, 0, 1.f, 1, 0, 0);
        conv_job_add(tab, nj, nbat, p.ws_gate, DSH, D, ws + WS_WSGU, D, 0, DSH, 2, 1, SC_GU, 1, 0, 0);
        conv_job_add(tab, nj, nbat, p.ws_up, DSH, D, ws + WS_WSGU, D, 0, DSH, 3, 1, SC_GU, 1, 0, 0);
        conv_job_add(tab, nj, nbat, p.ws_down, D, DSH, ws + WS_WSD, DSH, 0, D, 0, 1, SC_DN, 1, 0, 0);
        conv_job_add(tab, nj, nbat, p.w_gate, DEXP, D, ws + WS_WGU, D, 0, DEXP, 2, 1, SC_GU, NE, D * DEXP, 2 * DEXP * D);
        conv_job_add(tab, nj, nbat, p.w_up, DEXP, D, ws + WS_WGU, D, 0, DEXP, 3, 1, SC_GU, NE, D * DEXP, 2 * DEXP * D);
        tab[nj * CJ_WORDS + 14] = nbat; tab[255] = nj;
    }
    __syncthreads();
    const int nj = (int)tab[255], total = (int)tab[nj * CJ_WORDS + 14];
    unsigned* q = (unsigned*)(ws + WS_CTL) + CW_Q + 64;
    unsigned cur = 0;
    if (threadIdx.x == 0) cur = atomicAdd(q, 1u);
    for (;;) {
        if (threadIdx.x == 0) *shw = cur;
        lds_barrier();
        const int b = __builtin_amdgcn_readfirstlane((int)*shw);
        if (b >= total) break;
        if (threadIdx.x == 0) cur = atomicAdd(q, 1u);
        int j = 0;
        while (j + 1 < nj && b >= (int)tab[(j + 1) * CJ_WORDS + 14]) ++j;
        const LAS unsigned* t = tab + j * CJ_WORDS;
#define CJ(i) ((unsigned)__builtin_amdgcn_readfirstlane((int)t[i]))
        const float* src = (const float*)(const float GAS*)(((size_t)CJ(1) << 32) | CJ(0)); unsigned char* dst = (unsigned char*)(unsigned char GAS*)(((size_t)CJ(3) << 32) | CJ(2));
        const int ld = (int)CJ(4), dstLd = (int)CJ(5), koff = (int)CJ(6), tn = (int)CJ(7), per = (int)CJ(8), kind = (int)CJ(9), fp8 = (int)CJ(10); const float scale = __uint_as_float(CJ(11));
        const size_t sstr = CJ(12), dstr = CJ(13); const int b0 = (int)CJ(14);
#undef CJ
#pragma unroll 1
        for (int jj = 0; jj < 1; ++jj) {
            const int it = (b - b0) * 8 + wave, e = it / per, r = it % per, nt = r % tn, kt = r / tn;
            if (fp8) conv_item8(src + e * sstr, ld, dst + e * dstr, dstLd, kind, nt * 64, kt * 64, scale, img, lane);
            else conv_item(src + e * sstr, ld, (bf16*)dst + e * dstr, dstLd, koff, kind, nt * 64, kt * 64, img, lane);
        }
        lds_barrier();
    }
    lds_barrier();
}
__device__ __forceinline__ void conv_down_queue(const Params& p, LAS unsigned char* lds, volatile LAS unsigned* shw) {
    int tidl = threadIdx.x; asm volatile("" : "+v"(tidl));
    const int lane = tidl & 63, wave = tidl >> 6;
    LAS unsigned char* img = lds + wave * 9216;
    unsigned char* wsq = p.ws; asm volatile("" : "+s"(wsq));
    unsigned* q = (unsigned*)(wsq + WS_CTL) + CW_Q;
    constexpr int TN = D / 64, PER = TN * (DEXP / 64), NBATCH = PER * NE / 8;
    unsigned cur = 0;
    if (threadIdx.x == 0) cur = atomicAdd(q, 1u);
    for (;;) {
        if (threadIdx.x == 0) *shw = cur;
        lds_barrier();
        const unsigned b = *shw;
        if (b >= (unsigned)NBATCH) break;
        if (threadIdx.x == 0) cur = atomicAdd(q, 1u);
#pragma unroll 1
        for (int j = 0; j < 1; ++j) {
            const int it = (int)b * 8 + wave, e = it / PER, r = it % PER, nt = r % TN, kt = r / TN;
            conv_item8(p.w_down + (size_t)e * DEXP * D, D, p.ws + WS_WD + (size_t)e * D * DEXP, DEXP, 0, nt * 64, kt * 64, 32.f, img, lane);
        }
        lds_barrier();
    }
}

__device__ __forceinline__ void norm_row_load(const float* xrow, int lane, f32x4 (&v)[8], float& rstd) {
    const f32x4* xr = (const f32x4*)xrow + lane; float s = 0.f;
#pragma unroll
    for (int j = 0; j < 8; ++j) { v[j] = xr[64 * j]; s += (v[j].x * v[j].x + v[j].y * v[j].y) + (v[j].z * v[j].z + v[j].w * v[j].w); }
    rstd = rsqrtf(wave_sum(s) * (1.f / D) + EPS);
}
__device__ __forceinline__ void ph_norm1(const Params& p, int bid, int nb) {
    int tidl = threadIdx.x; asm volatile("" : "+v"(tidl));
    const int lane = tidl & 63, wave = tidl >> 6;
    const float* mod = (const float*)(p.ws + WS_MOD);
    bf16* H = (bf16*)(p.ws + WS_H);
    for (int idx = bid * NTHREADS + threadIdx.x; idx < D * NE; idx += nb * NTHREADS) {
        const int k = idx >> 6, e = idx & 63; const float v = p.router_w[idx]; const bf16 hi = f2bf(v);
        const int pos = (((((k >> 8) * 8 + ((k >> 5) & 7)) * 4 + (e & 3)) * 64 + ((k >> 3) & 3) * 16 + (e >> 2)) << 3) + (k & 7);
        ((bf16*)(p.ws + WS_RWH))[pos] = hi; ((bf16*)(p.ws + WS_RWL))[pos] = f2bf(v - bf2f(hi)); }
    f32x4 w[8];
#pragma unroll
    for (int j = 0; j < 8; ++j) w[j] = *(const f32x4*)(p.norm1_w + 4 * lane + 256 * j);
    for (int row = bid * 8 + wave; row < T; row += nb * 8) {
        const int b = row / SEQ; f32x4 v[8], sh[8], sc[8];
#pragma unroll
        for (int j = 0; j < 8; ++j) { v[j] = ((const f32x4*)(p.x + (size_t)row * D) + lane)[64 * j]; sh[j] = *(const f32x4*)(mod + b * 6 * D + 4 * lane + 256 * j); sc[j] = *(const f32x4*)(mod + b * 6 * D + D + 4 * lane + 256 * j); }
        asm volatile("" ::: "memory");
        asm volatile("" : "+v"(v[0]), "+v"(v[1]), "+v"(v[2]), "+v"(v[3]), "+v"(v[4]), "+v"(v[5]), "+v"(v[6]), "+v"(v[7]));
        asm volatile("" : "+v"(sh[0]), "+v"(sh[1]), "+v"(sh[2]), "+v"(sh[3]), "+v"(sh[4]), "+v"(sh[5]), "+v"(sh[6]), "+v"(sh[7]));
        asm volatile("" : "+v"(sc[0]), "+v"(sc[1]), "+v"(sc[2]), "+v"(sc[3]), "+v"(sc[4]), "+v"(sc[5]), "+v"(sc[6]), "+v"(sc[7]));
        float ss = 0.f;
#pragma unroll
        for (int j = 0; j < 8; ++j) ss += (v[j].x * v[j].x + v[j].y * v[j].y) + (v[j].z * v[j].z + v[j].w * v[j].w);
        const float rstd = rsqrtf(wave_sum(ss) * (1.f / D) + EPS);
#pragma unroll
        for (int j = 0; j < 8; ++j) {
            const int col = 4 * lane + 256 * j;
            const f32x4 y = v[j] * rstd * w[j] * (sc[j] + 1.0f) + sh[j];
            unsigned long long o = (unsigned long long)f2bf(y.x) | ((unsigned long long)f2bf(y.y) << 16) | ((unsigned long long)f2bf(y.z) << 32) | ((unsigned long long)f2bf(y.w) << 48);
            *(unsigned long long*)(H + (size_t)row * D + col) = o;
            *(unsigned*)(p.ws + WS_H8A + (size_t)row * D + col) = pk4_fp8(y.x, y.y, y.z, y.w);
        }
    }
}

struct GemmS { const bf16* A; int lda; const int* rowmap; const bf16* Bt; int ldb; int K; };
template <class Epi>
__device__ __forceinline__ void gemm_tile_simple(const GemmS& g, int brow, int bcol, LAS unsigned char* lds, const Epi& E) {
    LAS unsigned char* SA = lds; LAS unsigned char* SB = lds + 8192;
    const int tid = threadIdx.x, wid = tid >> 6, lane = tid & 63, wr = wid >> 2, wc = wid & 3, fr = lane & 15, fq = lane >> 4;
    const int ra = (tid * 16) / 64, ca = ((tid * 16) % 64) / 2;
    const int arow = g.rowmap ? g.rowmap[brow + ra] : brow + ra;
    const bf16* ga = g.A + (size_t)arow * g.lda + ca;
    const bf16* gb0 = g.Bt + (size_t)(bcol + ra) * g.ldb + ca;
    const bf16* gb1 = g.Bt + (size_t)(bcol + 128 + ra) * g.ldb + ca;
    f32x4 acc[4][4];
#pragma unroll
    for (int m = 0; m < 4; ++m)
#pragma unroll
        for (int n = 0; n < 4; ++n) acc[m][n] = (f32x4){0.f, 0.f, 0.f, 0.f};
    for (int kt = 0; kt < g.K; kt += 32) {
        __builtin_amdgcn_global_load_lds((const unsigned*)(ga + kt), (LAS unsigned*)(SA + tid * 16), 16, 0, 0);
        __builtin_amdgcn_global_load_lds((const unsigned*)(gb0 + kt), (LAS unsigned*)(SB + tid * 16), 16, 0, 0);
        __builtin_amdgcn_global_load_lds((const unsigned*)(gb1 + kt), (LAS unsigned*)(SB + 8192 + tid * 16), 16, 0, 0);
        asm volatile("s_waitcnt vmcnt(0)" ::: "memory"); __syncthreads();
        bf16x8 At[4], Bl[4];
#pragma unroll
        for (int m = 0; m < 4; ++m) At[m] = *(const LAS bf16x8*)(SA + (wr * 64 + m * 16 + fr) * 64 + fq * 16);
#pragma unroll
        for (int n = 0; n < 4; ++n) Bl[n] = *(const LAS bf16x8*)(SB + (wc * 64 + n * 16 + fr) * 64 + fq * 16);
#pragma unroll
        for (int m = 0; m < 4; ++m)
#pragma unroll
            for (int n = 0; n < 4; ++n) acc[m][n] = __builtin_amdgcn_mfma_f32_16x16x32_bf16(At[m], Bl[n], acc[m][n], 0, 0, 0);
        __syncthreads();
    }
#pragma unroll
    for (int m = 0; m < 4; ++m)
#pragma unroll
        for (int n = 0; n < 4; ++n)
#pragma unroll
            for (int j = 0; j < 4; ++j) E(brow + wr * 64 + m * 16 + fq * 4 + j, bcol + wc * 64 + n * 16 + fr, acc[m][n][j]);
}


namespace pg8 {
constexpr int BM = 256, BK = 64, HALF = 128, HTB = HALF * BK * 2, STAGE_BYTES = 8 * HTB, NXCD = 8, WGM = 8;
__host__ __device__ __forceinline__ int lds_byte(int r, int c) { const int st = (r >> 4) * 2 + (c >> 5), rr = r & 15, cc = c & 31, ob = rr * 64 + cc * 2; return st * 1024 + (ob ^ (((ob >> 9) & 1) << 5)); }
__host__ __device__ __forceinline__ void stage_rc(int b, int& R, int& C) { const int st = b / 1024, sb = b % 1024, swz = sb ^ (((sb >> 9) & 1) << 5); R = (st >> 1) * 16 + swz / 64; C = (st & 1) * 32 + (swz % 64) / 2; }
__host__ __device__ __forceinline__ int perm32(int rho) { const int n = rho >> 4, i = rho & 15; return 8 * (i >> 2) + 4 * n + (i & 3); }
typedef float f32x2n __attribute__((ext_vector_type(2)));
typedef __bf16 bf16x2n __attribute__((ext_vector_type(2)));
__device__ __forceinline__ unsigned cvt_pk_bf16(float lo, float hi) { const f32x2n v = {lo, hi}; return __builtin_bit_cast(unsigned, __builtin_convertvector(v, bf16x2n)); }
__device__ __forceinline__ u32x4 pack8(const f32x4& a, const f32x4& b) { u32x4 w; w.x = cvt_pk_bf16(a[0], a[1]); w.y = cvt_pk_bf16(a[2], a[3]); w.z = cvt_pk_bf16(b[0], b[1]); w.w = cvt_pk_bf16(b[2], b[3]); return w; }
__device__ __forceinline__ void unpack8(const u32x4& w, f32x4& a, f32x4& b) {
    a[0] = __uint_as_float(w.x << 16); a[1] = __uint_as_float(w.x & 0xffff0000u); a[2] = __uint_as_float(w.y << 16); a[3] = __uint_as_float(w.y & 0xffff0000u);
    b[0] = __uint_as_float(w.z << 16); b[1] = __uint_as_float(w.z & 0xffff0000u); b[2] = __uint_as_float(w.w << 16); b[3] = __uint_as_float(w.w & 0xffff0000u); }

struct Unit { int pm, pn; int orow0; int e; int kind; const char* Bp; };
__device__ __forceinline__ bool static_tile(int i, int G, int c, int nM, int nN, int& pm, int& pn) {
    const int nwg = nM * nN; const long L = (long)i * G + c; if (L >= nwg) return false;
    int wgid = (int)L; { const int q = nwg / NXCD, r = nwg % NXCD, xcd = wgid % NXCD, off = wgid / NXCD; wgid = (xcd < r ? xcd * (q + 1) : r * (q + 1) + (xcd - r) * q) + off; }
    const int nig = WGM * nN, gid = wgid / nig, fm = gid * WGM, gsz = (nM - fm) < WGM ? (nM - fm) : WGM;
    pm = fm + ((wgid % nig) % gsz); pn = (wgid % nig) / gsz; return true;
}
struct DenseSched {
    const bf16* A; int lda; const bf16* Bt; int ldb; int K; int nM, nN, G, c; int i0 = 0, i1 = 1 << 30;
    __device__ __forceinline__ bool next(int i, Unit& u) const { int pm, pn; i += i0; if (i >= i1) return false; if (!static_tile(i, G, c, nM, nN, pm, pn)) return false;
        u.pm = pm; u.pn = pn; u.orow0 = pm * BM; u.e = 0; u.kind = 0; u.Bp = (const char*)Bt + (size_t)pn * BM * ldb; return true; }
    static constexpr bool GATHER_A = false, FP8 = false; static constexpr int sA = 127, sB = 127;
    __device__ __forceinline__ void a_offsets(const Unit&, int, unsigned (&)[2][2]) const {}
};

typedef int i32x4v __attribute__((ext_vector_type(4)));
typedef int i32x8v __attribute__((ext_vector_type(8)));
__device__ __forceinline__ i32x8v cat8(bf16x8 lo, bf16x8 hi) { return __builtin_shufflevector(__builtin_bit_cast(i32x4v, lo), __builtin_bit_cast(i32x4v, hi), 0, 1, 2, 3, 4, 5, 6, 7); }
template <int SA_, int SB_> struct DenseSched8 : DenseSched { static constexpr bool FP8 = true; static constexpr int sA = SA_, sB = SB_; };
template <class Epi, class Sched, bool ALIGN_EPI, bool HAS_MID, bool RELAX = false>
__device__ __forceinline__ void gemm_phase(LAS unsigned char* lds, const Sched& S, const Epi& E, int midt) {
    constexpr bool GA = Sched::GATHER_A;
    int tid = threadIdx.x; asm volatile("" : "+v"(tid));
    const int wid = __builtin_amdgcn_readfirstlane(tid >> 6), lane = tid & 63, wr = wid >> 2, wc = wid & 3, fr = lane & 15, fq = lane >> 4;
    const int K = S.K, nt = K / (BK * 2), ldb = S.ldb, lda = S.lda;
    unsigned voffB[2], voffA[2];
#pragma unroll
    for (int i = 0; i < 2; ++i) { int R, C; stage_rc(tid * 16 + i * 8192, R, C); int Rb = Epi::PERM ? ((R & ~31) + perm32(R & 31)) : R;
        if constexpr (Epi::PERM16) Rb = (R >> 5) * 64 + ((R >> 2) & 3) * 16 + ((R >> 4) & 1) * 4 + (R & 3);
        voffB[i] = (unsigned)(Rb * ldb + C * 2); voffA[i] = (unsigned)(R * lda + C * 2); }
    const size_t kstep = (size_t)(BK * 2);
    const size_t hstepB = (size_t)(Epi::PERM16 ? 8 : HALF) * ldb, hstepA = (size_t)HALF * lda;
    const unsigned ldsw = (unsigned)wid * 1024u;
    const int aoff = lds_byte(wr * 64 + fr, fq * 8), boff = lds_byte(wc * 32 + fr, fq * 8);
    const char* Abase = (const char*)S.A;
#define PG8_SA(b, h) (((b) * 2 + (h)) * HTB)
#define PG8_SB(b, h) ((4 + (b) * 2 + (h)) * HTB)
#define PG8_STAGE(bufoff, gbase, voff) do { _Pragma("unroll") for (int _i = 0; _i < 2; ++_i) \
        __builtin_amdgcn_global_load_lds((const unsigned*)((const char*)(gbase) + (voff)[_i]), (LAS unsigned*)(lds + (bufoff) + ldsw + _i * 8192), 16, 0, 0); } while (0)
#define PG8_STAGE_AC(bufoff, h, kb) do { if constexpr (GA) { PG8_STAGE(bufoff, Abase + (kb), vc[h]); } else { PG8_STAGE(bufoff, cA + (h) * hstepA + (kb), voffA); } } while (0)
#define PG8_STAGE_AN(bufoff, h, kb) do { if constexpr (GA) { PG8_STAGE(bufoff, ag2 + (kb), v2[h]); } \
        else { PG8_STAGE(bufoff, a2 + (h) * hstepA + (kb), voffA); } } while (0)
#define PG8_LDA(dst, b, h) do { _Pragma("unroll") for (int m = 0; m < 4; ++m) { if constexpr (Sched::FP8) dst##8[m] = cat8(*(const LAS bf16x8*)(lds + PG8_SA(b, h) + aoff + m * 2048), *(const LAS bf16x8*)(lds + PG8_SA(b, h) + aoff + m * 2048 + 1024)); \
        else { _Pragma("unroll") for (int k = 0; k < 2; ++k) dst[m][k] = *(const LAS bf16x8*)(lds + PG8_SA(b, h) + aoff + m * 2048 + k * 1024); } } } while (0)
#define PG8_LDB(dst, b, h) do { _Pragma("unroll") for (int n = 0; n < 2; ++n) { if constexpr (Sched::FP8) dst##8[n] = cat8(*(const LAS bf16x8*)(lds + PG8_SB(b, h) + boff + n * 2048), *(const LAS bf16x8*)(lds + PG8_SB(b, h) + boff + n * 2048 + 1024)); \
        else { _Pragma("unroll") for (int k = 0; k < 2; ++k) dst[n][k] = *(const LAS bf16x8*)(lds + PG8_SB(b, h) + boff + n * 2048 + k * 1024); } } } while (0)
#define PG8_MMA(ai, bj, At, Bt) do { __builtin_amdgcn_s_setprio(1); _Pragma("unroll") for (int m = 0; m < 4; ++m) _Pragma("unroll") for (int n = 0; n < 2; ++n) { \
        if constexpr (Sched::FP8) asm volatile("v_mfma_scale_f32_16x16x128_f8f6f4 %0, %1, %2, %0, %3, %4 op_sel_hi:[0,0,0]" : "+v"(acc[ai][bj][m][n]) : "v"(Bt##8[n]), "v"(At##8[m]), "v"(scB), "v"(scA)); \
        else { _Pragma("unroll") for (int k = 0; k < 2; ++k) acc[ai][bj][m][n] = __builtin_amdgcn_mfma_f32_16x16x32_bf16(Bt[n][k], At[m][k], acc[ai][bj][m][n], 0, 0, 0); } } \
        __builtin_amdgcn_s_setprio(0); } while (0)
#define PG8_WAIT_V(n) asm volatile("s_waitcnt vmcnt(" #n ")" ::: "memory")
#define PG8_WAIT_L(n) asm volatile("s_waitcnt lgkmcnt(" #n ")" ::: "memory")
#define PG8_WAIT_RLX() do { if (sr >= 32) PG8_WAIT_V(40); else if (sr >= 16) PG8_WAIT_V(24); else PG8_WAIT_V(16); } while (0)
#define PG8_BAR __builtin_amdgcn_s_barrier()
#define PG8_SCHED __builtin_amdgcn_sched_barrier(0)
    Unit cur, nxt; int ui = 0, sr = 8;
    if (!S.next(0, cur)) return;
    f32x4 acc[2][2][4][2];
#pragma unroll
    for (int a = 0; a < 2; ++a)
#pragma unroll
        for (int b = 0; b < 2; ++b)
#pragma unroll
            for (int m = 0; m < 4; ++m)
#pragma unroll
                for (int n = 0; n < 2; ++n) acc[a][b][m][n] = (f32x4){0.f, 0.f, 0.f, 0.f};
    int scA = Sched::sA, scB = Sched::sB;
    bf16x8 At[4][2], B0[2][2], B1[2][2];
    i32x8v At8[4], B08[2], B18[2];
    unsigned vc[2][2], vn[2][2];
    if constexpr (GA) S.a_offsets(cur, 0, vc);
    const char* cA = Abase + (size_t)cur.orow0 * lda;
    const char* cB = cur.Bp;
    PG8_STAGE(PG8_SB(0, 0), cB, voffB); PG8_STAGE(PG8_SB(0, 1), cB + hstepB, voffB); PG8_STAGE_AC(PG8_SA(0, 0), 0, 0); PG8_STAGE_AC(PG8_SA(0, 1), 1, 0);
    if (wr == 1) PG8_BAR;
    PG8_WAIT_V(2); PG8_BAR;
    PG8_STAGE(PG8_SB(1, 0), cB + kstep, voffB); PG8_STAGE_AC(PG8_SA(1, 0), 0, kstep); PG8_STAGE(PG8_SB(1, 1), cB + hstepB + kstep, voffB);
    PG8_WAIT_V(6); PG8_BAR;
    for (;;) {
        const bool has_next = S.next(ui + 1, nxt);
        if constexpr (GA) {
            if (has_next) S.a_offsets(nxt, ui + 1, vn);
            else {
#pragma unroll
                for (int h = 0; h < 2; ++h)
#pragma unroll
                    for (int j = 0; j < 2; ++j) vn[h][j] = vc[h][j];
            }
        }
        const char* nA = has_next ? Abase + (size_t)nxt.orow0 * lda : cA;
        const char* nB = has_next ? nxt.Bp : cB;
#define PG8_TRIP(RLX) do { \
            const bool last = (t == nt - 2); \
            if (HAS_MID) { if (t == midt) E.mid(acc, cur, wr, wc, fr, fq); } \
            const char* a2 = last ? nA : cA + (size_t)(t + 2) * kstep; const char* b2 = last ? nB : cB + (size_t)(t + 2) * kstep; \
            const char* b3 = b2 + kstep; \
            const char* ag2 = last ? Abase : Abase + (size_t)(t + 2) * kstep;        \
            unsigned v2[2][2]; \
            if constexpr (GA) { \
                _Pragma("unroll") for (int h = 0; h < 2; ++h) \
                _Pragma("unroll") for (int j = 0; j < 2; ++j) v2[h][j] = last ? vn[h][j] : vc[h][j]; \
            } \
              \
            PG8_LDB(B0, 0, 0); PG8_LDB(B1, 0, 1); PG8_SCHED; PG8_LDA(At, 0, 0); if (!(RLX)) PG8_STAGE_AC(PG8_SA(1, 1), 1, (size_t)(t + 1) * kstep); \
            if (RLX) PG8_WAIT_RLX(); else PG8_WAIT_V(8); PG8_WAIT_L(0); PG8_BAR; PG8_MMA(0, 0, At, B0); PG8_MMA(0, 1, At, B1); PG8_BAR; PG8_SCHED; \
              \
            PG8_LDA(At, 0, 1); PG8_STAGE(PG8_SB(0, 0), b2, voffB); PG8_STAGE(PG8_SB(0, 1), b2 + hstepB, voffB); PG8_STAGE_AN(PG8_SA(0, 0), 0, 0); \
            if (RLX) PG8_WAIT_RLX(); else PG8_WAIT_V(8); PG8_WAIT_L(0); PG8_BAR; PG8_MMA(1, 0, At, B0); PG8_MMA(1, 1, At, B1); PG8_BAR; PG8_SCHED; \
              \
            PG8_LDB(B0, 1, 0); PG8_LDB(B1, 1, 1); PG8_SCHED; PG8_LDA(At, 1, 0); PG8_STAGE_AN(PG8_SA(0, 1), 1, 0); \
            if (RLX) PG8_WAIT_RLX(); else PG8_WAIT_V(8); PG8_WAIT_L(0); PG8_BAR; PG8_MMA(0, 0, At, B0); PG8_MMA(0, 1, At, B1); PG8_BAR; PG8_SCHED; \
              \
            PG8_LDA(At, 1, 1); PG8_STAGE(PG8_SB(1, 0), b3, voffB); PG8_STAGE(PG8_SB(1, 1), b3 + hstepB, voffB); PG8_STAGE_AN(PG8_SA(1, 0), 0, kstep); \
            PG8_WAIT_V(8); PG8_WAIT_L(0); PG8_BAR; PG8_MMA(1, 0, At, B0); PG8_MMA(1, 1, At, B1); PG8_BAR; PG8_SCHED; \
        } while (0)
        int t = 0;
        if constexpr (RELAX) { if (ui > 0) { PG8_TRIP(1); t = 2; } }
        for (; t < nt; t += 2) { PG8_TRIP(0); }
#undef PG8_TRIP
        if (RELAX && has_next) {
            if constexpr (GA) { PG8_STAGE(PG8_SA(1, 1), Abase + kstep, vn[1]); } else { PG8_STAGE(PG8_SA(1, 1), nA + hstepA + kstep, voffA); }
            asm volatile("" ::: "memory"); PG8_SCHED;
        }
        if constexpr (ALIGN_EPI) { if (wr == 0) PG8_BAR; }
        if constexpr (Sched::FP8) {
            asm volatile("s_nop 15\n\ts_nop 15" : "+v"(acc[1][0][0][0]), "+v"(acc[1][0][0][1]), "+v"(acc[1][0][1][0]), "+v"(acc[1][0][1][1]), "+v"(acc[1][0][2][0]), "+v"(acc[1][0][2][1]), "+v"(acc[1][0][3][0]), "+v"(acc[1][0][3][1]));
            asm volatile("" : "+v"(acc[1][1][0][0]), "+v"(acc[1][1][0][1]), "+v"(acc[1][1][1][0]), "+v"(acc[1][1][1][1]), "+v"(acc[1][1][2][0]), "+v"(acc[1][1][2][1]), "+v"(acc[1][1][3][0]), "+v"(acc[1][1][3][1]));
        }
        E(acc, cur, wr, wc, fr, fq);
        asm volatile("" ::: "memory"); PG8_SCHED;
        if (!has_next) break;
        sr = E.vm_min(cur);
#pragma unroll
        for (int a = 0; a < 2; ++a)
#pragma unroll
            for (int b = 0; b < 2; ++b)
#pragma unroll
                for (int m = 0; m < 4; ++m)
#pragma unroll
                    for (int n = 0; n < 2; ++n) acc[a][b][m][n] = (f32x4){0.f, 0.f, 0.f, 0.f};
        cur = nxt; cA = nA; cB = nB; ++ui;
        if constexpr (GA) {
#pragma unroll
            for (int h = 0; h < 2; ++h)
#pragma unroll
                for (int j = 0; j < 2; ++j) vc[h][j] = vn[h][j];
        }
        if constexpr (ALIGN_EPI) { if (wr == 1) PG8_BAR; }
    }
    PG8_WAIT_V(0);
    if constexpr (!ALIGN_EPI) { if (wr == 0) PG8_BAR; }
    PG8_BAR;
#undef PG8_SA
#undef PG8_SB
#undef PG8_STAGE
#undef PG8_STAGE_AC
#undef PG8_STAGE_AN
#undef PG8_LDA
#undef PG8_LDB
#undef PG8_MMA
#undef PG8_WAIT_V
#undef PG8_WAIT_L
#undef PG8_WAIT_RLX
#undef PG8_BAR
#undef PG8_SCHED
}

#define PG8_FOR_ROWS(u) _Pragma("unroll") for (int ai = 0; ai < 2; ++ai) _Pragma("unroll") for (int m = 0; m < 4; ++m)
struct EpiInF {
    static constexpr bool PERM = true, PERM16 = false;
    unsigned char* ws; int pn_off;
    __device__ __forceinline__ void operator()(const f32x4 (&acc)[2][2][4][2], const Unit& u, int wr, int wc, int fr, int fq) const {
        const int pn = u.pn + pn_off; const float* rot = (const float*)(ws + WS_ROT);
        if (pn < 8) {
#pragma unroll
            for (int ai = 0; ai < 2; ++ai) {
                f32x4 rq[4][2];
#pragma unroll
                for (int m = 0; m < 4; ++m) { const int row = u.orow0 + ai * HALF + wr * 64 + m * 16 + fr, pos = row & (SEQ - 1);
                    const float* rp = rot + ((size_t)pos * 64 + ((wc * 32 + 8 * fq) >> 1)) * 2; rq[m][0] = *(const f32x4*)rp; rq[m][1] = *(const f32x4*)(rp + 4); }
                asm volatile("" ::: "memory");
                asm volatile("" : "+v"(rq[0][0]), "+v"(rq[0][1]), "+v"(rq[1][0]), "+v"(rq[1][1]), "+v"(rq[2][0]), "+v"(rq[2][1]), "+v"(rq[3][0]), "+v"(rq[3][1]));
#pragma unroll
                for (int m = 0; m < 4; ++m) { const int row = u.orow0 + ai * HALF + wr * 64 + m * 16 + fr;
                    bf16* dst = (bf16*)(ws + (pn < 4 ? WS_Q : WS_K)) + (size_t)row * 1024 + (pn & 3) * 256;
                    const f32x4 r0 = rq[m][0], r1 = rq[m][1];
#pragma unroll
                    for (int bj = 0; bj < 2; ++bj) {
                        const int cl = bj * HALF + wc * 32 + 8 * fq;
                        const f32x4 a = acc[ai][bj][m][0], b = acc[ai][bj][m][1];
                        f32x4 oa, ob;
                        oa[0] = a[0] * r0[0] - a[1] * r0[1]; oa[1] = a[0] * r0[1] + a[1] * r0[0];
                        oa[2] = a[2] * r0[2] - a[3] * r0[3]; oa[3] = a[2] * r0[3] + a[3] * r0[2];
                        ob[0] = b[0] * r1[0] - b[1] * r1[1]; ob[1] = b[0] * r1[1] + b[1] * r1[0];
                        ob[2] = b[2] * r1[2] - b[3] * r1[3]; ob[3] = b[2] * r1[3] + b[3] * r1[2];
                        *(u32x4*)(dst + cl) = pack8(oa, ob);
                    }
                }
                asm volatile("" ::: "memory");
            }
            return;
        }
        PG8_FOR_ROWS(u) {
            const int row = u.orow0 + ai * HALF + wr * 64 + m * 16 + fr;
            if (pn < 8) {
            } else if (pn < 20) {
                bf16* dst = (bf16*)(ws + (pn < 12 ? WS_V : pn < 16 ? WS_G : WS_CB)) + (size_t)row * 1024 + (pn & 3) * 256;
#pragma unroll
                for (int bj = 0; bj < 2; ++bj) {
                    const int cl = bj * HALF + wc * 32 + 8 * fq;
                    f32x4 a = acc[ai][bj][m][0], b = acc[ai][bj][m][1];
                    if (pn >= 12 && pn < 16) {
#pragma unroll
                        for (int j = 0; j < 4; ++j) { a[j] = silu_f(a[j]); b[j] = silu_f(b[j]); }
                    }
                    *(u32x4*)(dst + cl) = pack8(a, b);
                }
            } else if (pn < 28) {
                const int cl = wc * 32 + 8 * fq;
                const f32x4 a = acc[ai][0][m][0] * acc[ai][1][m][0], b = acc[ai][0][m][1] * acc[ai][1][m][1];
                *(u32x4*)((bf16*)(ws + WS_UP) + (size_t)row * 1024 + (pn - 20) * 128 + cl) = pack8(a, b);
            } else {
                bf16* dst = (bf16*)(ws + (pn < 36 ? WS_GR : WS_GC)) + (size_t)row * 2048 + (pn < 36 ? pn - 28 : pn - 36) * 256;
#pragma unroll
                for (int bj = 0; bj < 2; ++bj) {
                    const int cl = bj * HALF + wc * 32 + 8 * fq;
                    f32x4 a = acc[ai][bj][m][0], b = acc[ai][bj][m][1];
#pragma unroll
                    for (int j = 0; j < 4; ++j) { a[j] = sigmoid_f(a[j]); b[j] = sigmoid_f(b[j]); }
                    *(u32x4*)(dst + cl) = pack8(a, b);
                }
            }
        }
    }
    __device__ __forceinline__ void mid(f32x4 (&)[2][2][4][2], const Unit&, int, int, int, int) const {}
    __device__ __forceinline__ int vm_min(const Unit& u) const { const int pn = u.pn + pn_off; return (pn >= 20 && pn < 28) ? 8 : 16; }
};
struct EpiMergeF {
    static constexpr bool PERM = true, PERM16 = false;
    bf16* M; const bf16 *GR, *GC;
    __device__ __forceinline__ void mid(f32x4 (&acc)[2][2][4][2], const Unit& u, int wr, int wc, int fr, int fq) const {
        unsigned base = (unsigned)((u.orow0 + wr * 64 + fr) * 2048 + u.pn * BM + wc * 32 + 8 * fq);
        asm volatile("" : "+v"(base));
#pragma unroll
        for (int ai = 0; ai < 2; ++ai) {
            u32x4 gr[8], gc[8];
#pragma unroll
            for (int m = 0; m < 4; ++m)
#pragma unroll
                for (int bj = 0; bj < 2; ++bj) { const unsigned o = base + (unsigned)((ai * HALF + m * 16) * 2048 + bj * HALF); gr[m * 2 + bj] = *(const u32x4*)(GR + o); gc[m * 2 + bj] = *(const u32x4*)(GC + o); }
            asm volatile("" ::: "memory");
            asm volatile("" : "+v"(gr[0]), "+v"(gr[1]), "+v"(gr[2]), "+v"(gr[3]), "+v"(gr[4]), "+v"(gr[5]), "+v"(gr[6]), "+v"(gr[7]));
            asm volatile("" : "+v"(gc[0]), "+v"(gc[1]), "+v"(gc[2]), "+v"(gc[3]), "+v"(gc[4]), "+v"(gc[5]), "+v"(gc[6]), "+v"(gc[7]));
#pragma unroll
            for (int m = 0; m < 4; ++m) {
#pragma unroll
                for (int bj = 0; bj < 2; ++bj) {
                    f32x4 ra, rb, ca, cb; unpack8(gr[m * 2 + bj], ra, rb); unpack8(gc[m * 2 + bj], ca, cb);
#pragma unroll
                    for (int j = 0; j < 4; ++j) { acc[ai][bj][m][0][j] *= ra[j] * __builtin_amdgcn_rcpf(fmaxf(ca[j], 1e-18f)); acc[ai][bj][m][1][j] *= rb[j] * __builtin_amdgcn_rcpf(fmaxf(cb[j], 1e-18f)); }
                }
                asm volatile("" : "+v"(acc[ai][0][m][0]), "+v"(acc[ai][0][m][1]), "+v"(acc[ai][1][m][0]), "+v"(acc[ai][1][m][1]) :: "memory");
            }
        }
    }
    __device__ __forceinline__ void operator()(const f32x4 (&acc)[2][2][4][2], const Unit& u, int wr, int wc, int fr, int fq) const {
        const size_t o0 = (size_t)(u.orow0 + wr * 64 + fr) * 2048 + u.pn * BM + wc * 32 + 8 * fq;
        u32x4 gc[16];
#pragma unroll
        for (int t = 0; t < 16; ++t) gc[t] = *(const u32x4*)(GC + o0 + (size_t)(((t >> 3) * HALF + ((t >> 1) & 3) * 16) * 2048 + (t & 1) * HALF));
        asm volatile("" ::: "memory");
        asm volatile("" : "+v"(gc[0]), "+v"(gc[1]), "+v"(gc[2]), "+v"(gc[3]), "+v"(gc[4]), "+v"(gc[5]), "+v"(gc[6]), "+v"(gc[7]));
        asm volatile("" : "+v"(gc[8]), "+v"(gc[9]), "+v"(gc[10]), "+v"(gc[11]), "+v"(gc[12]), "+v"(gc[13]), "+v"(gc[14]), "+v"(gc[15]));
#pragma unroll
        for (int t = 0; t < 16; ++t) { const int ai = t >> 3, m = (t >> 1) & 3, bj = t & 1;
            f32x4 ca, cb; unpack8(gc[t], ca, cb);
#pragma unroll
            for (int j = 0; j < 4; ++j) { ca[j] = fmaxf(ca[j], 1e-18f); cb[j] = fmaxf(cb[j], 1e-18f); }
            *(u32x4*)(M + o0 + (size_t)((ai * HALF + m * 16) * 2048 + bj * HALF)) = pack8(acc[ai][bj][m][0] * ca, acc[ai][bj][m][1] * cb);
        }
    }
    __device__ __forceinline__ int vm_min(const Unit&) const { return 32; }
};
struct EpiRes1F {
    static constexpr bool PERM = false, PERM16 = false;
    const float* x; float* o; const float* mod;
    __device__ __forceinline__ void operator()(const f32x4 (&acc)[2][2][4][2], const Unit& u, int wr, int wc, int fr, int fq) const {
        const int b = u.orow0 / SEQ;
        f32x4 g[2][2];
#pragma unroll
        for (int bj = 0; bj < 2; ++bj)
#pragma unroll
            for (int n = 0; n < 2; ++n) g[bj][n] = *(const f32x4*)(mod + b * 6 * D + 2 * D + u.pn * BM + bj * HALF + wc * 32 + n * 16 + 4 * fq);
        f32x4 xq[2][4];
        const size_t i0 = (size_t)(u.orow0 + wr * 64 + fr) * 2048 + u.pn * BM + wc * 32 + 4 * fq;
#define RES1_LOAD(Q, AI, M) do { _Pragma("unroll") for (int bj = 0; bj < 2; ++bj) _Pragma("unroll") for (int n = 0; n < 2; ++n) \
            xq[Q][bj * 2 + n] = *(const f32x4*)(x + i0 + (size_t)((AI) * HALF + (M) * 16) * 2048 + bj * HALF + n * 16); } while (0)
        RES1_LOAD(0, 0, 0);
#pragma unroll
        for (int t = 0; t < 8; ++t) {
            const int ai = t >> 2, m = t & 3, q = t & 1;
            if (t < 7) RES1_LOAD(q ^ 1, (t + 1) >> 2, (t + 1) & 3);
            asm volatile("" ::: "memory");
            asm volatile("" : "+v"(xq[q][0]), "+v"(xq[q][1]), "+v"(xq[q][2]), "+v"(xq[q][3]));
#pragma unroll
            for (int bj = 0; bj < 2; ++bj)
#pragma unroll
                for (int n = 0; n < 2; ++n) *(f32x4*)(o + i0 + (size_t)(ai * HALF + m * 16) * 2048 + bj * HALF + n * 16) = xq[q][bj * 2 + n] + g[bj][n] * acc[ai][bj][m][n];
            asm volatile("" ::: "memory");
        }
#undef RES1_LOAD
    }
    __device__ __forceinline__ void mid(f32x4 (&)[2][2][4][2], const Unit&, int, int, int, int) const {}
    __device__ __forceinline__ int vm_min(const Unit&) const { return 32; }
};
constexpr int MOE_LDS_CNT = 131072 + 512 + 2560 + 12288 + 128;
constexpr int MOE_LDS_BASE = 131072, MOE_LDS_RT2E = 131072 + 512, MOE_LDS_ROWMAP = 131072 + 512 + 2560, MOE_MAXU = 12, MOE_LDS_UTAB = 131072 + 512 + 2560 + 12288, MOE_UTAB_N = 32;
__device__ __forceinline__ int moe_base_tables(const unsigned* ctl, LAS unsigned char* lds) {
    LAS int* base = (LAS int*)(lds + MOE_LDS_BASE); LAS int* cnt = (LAS int*)(lds + MOE_LDS_CNT);
    int tidl = threadIdx.x; asm volatile("" : "+v"(tidl));
    if (tidl < 64) {
        const int e = tidl, c = (int)ctl[CW_CNT + 64 * e], pad = (c + 255) & ~255;
        int incl = pad;
#pragma unroll
        for (int o = 1; o < 64; o <<= 1) { const int v = __shfl_up(incl, o); if (e >= o) incl += v; }
        base[e] = incl - pad; cnt[e] = c; if (e == 63) base[64] = incl;
    }
    __syncthreads();
    return __builtin_amdgcn_readfirstlane(base[64]);
}
template <bool GATHER, bool F8, int SA_, int SB_> struct MoeSched {
    const bf16* A; int lda; int ldb; int K; int nM, nN, G, c; int total_rt;
    const char* Brouted; size_t estride; const char* Bshared; LAS unsigned char* lds;
    __device__ __forceinline__ void setup(const int* ltok) const {
        LAS int* base = (LAS int*)(lds + MOE_LDS_BASE); LAS int* cnt = (LAS int*)(lds + MOE_LDS_CNT); LAS int* rt2e = (LAS int*)(lds + MOE_LDS_RT2E); LAS int* rowmap = (LAS int*)(lds + MOE_LDS_ROWMAP);
        for (int rt = threadIdx.x; rt < total_rt; rt += NTHREADS) { int lo = 0, hi = NE - 1;
            while (lo < hi) { const int mid = (lo + hi + 1) >> 1; if (base[mid] <= rt * 256) lo = mid; else hi = mid - 1; }
            rt2e[rt] = lo; }
        LAS int* utab = (LAS int*)(lds + MOE_LDS_UTAB);
        if (threadIdx.x < MOE_UTAB_N) { int pm, pn; int ut = -1;
            if (static_tile((int)threadIdx.x, G, c, nM, nN, pm, pn)) { const int c0 = pm * 64 / nM, c1 = (pm + 1) * 64 / nM; pm = (c1 > c0) ? total_rt + c0 : pm - c0; ut = pm | (pn << 16); }
            utab[threadIdx.x] = ut; }
        __syncthreads();
        if (GATHER) {
            static_assert(MOE_MAXU == 12, "six passes of two units");
            int tok[6]; const int r = (int)threadIdx.x & 255, ih = (int)threadIdx.x >> 8;
#pragma unroll
            for (int k = 0; k < 6; ++k) { const int i = 2 * k + ih, ut = utab[i]; int t = 0;
                if (ut >= 0) { const int pm = ut & 0xffff;
                    if (pm < total_rt) { const int e = rt2e[pm], pos = pm * 256 + r - base[e]; if (pos < cnt[e]) t = ltok[(size_t)e * T + pos]; }
                    else t = (pm - total_rt) * 256 + r; }
                tok[k] = t; }
            asm volatile("" ::: "memory");
            asm volatile("" : "+v"(tok[0]), "+v"(tok[1]), "+v"(tok[2]), "+v"(tok[3]), "+v"(tok[4]), "+v"(tok[5]));
#pragma unroll
            for (int k = 0; k < 6; ++k) { const int i = 2 * k + ih; if (utab[i] >= 0) rowmap[i * 256 + r] = tok[k]; }
        }
        asm volatile("s_waitcnt vmcnt(0) lgkmcnt(0)" ::: "memory");
        __syncthreads();
    }
    __device__ __forceinline__ bool next(int i, Unit& u) const {
        if (i >= MOE_UTAB_N) return false;
        const int ut = __builtin_amdgcn_readfirstlane(((const LAS int*)(lds + MOE_LDS_UTAB))[i]); if (ut < 0) return false;
        const int pm = ut & 0xffff, pn = ut >> 16;
        u.pm = pm; u.pn = pn;
        if (pm < total_rt) { const LAS int* rt2e = (const LAS int*)(lds + MOE_LDS_RT2E); const int e = __builtin_amdgcn_readfirstlane(rt2e[pm]);
            u.kind = 0; u.e = e; u.orow0 = pm * BM; u.Bp = Brouted + (size_t)e * estride + (size_t)pn * BM * ldb; }
        else { u.kind = 1; u.e = 0; u.orow0 = CAP + (pm - total_rt) * BM; u.Bp = Bshared + (size_t)pn * BM * ldb; }
        return true;
    }
    static constexpr bool GATHER_A = GATHER, FP8 = F8; static constexpr int sA = SA_, sB = SB_;
    __device__ __forceinline__ void a_offsets(const Unit& u, int i, unsigned (&v)[2][2]) const {
        const LAS int* rowmap = (const LAS int*)(lds + MOE_LDS_ROWMAP);
#pragma unroll
        for (int j = 0; j < 2; ++j) { int R, C; stage_rc((int)threadIdx.x * 16 + j * 8192, R, C);
#pragma unroll
            for (int h = 0; h < 2; ++h) v[h][j] = (unsigned)(rowmap[i * 256 + h * HALF + R] * lda + C * 2); }
    }
};
struct EpiGUF {
    static constexpr bool PERM = true, PERM16 = false;
    unsigned char* ACT;
    __device__ __forceinline__ void operator()(const f32x4 (&acc)[2][2][4][2], const Unit& u, int wr, int wc, int fr, int fq) const {
        PG8_FOR_ROWS(u) {
            const int row = u.orow0 + ai * HALF + wr * 64 + m * 16 + fr;
            f32x4 a, b;
#pragma unroll
            for (int j = 0; j < 4; ++j) { a[j] = 4.f * silu_f(acc[ai][0][m][0][j]) * acc[ai][1][m][0][j]; b[j] = 4.f * silu_f(acc[ai][0][m][1][j]) * acc[ai][1][m][1][j]; }
            *(unsigned long long*)(ACT + (size_t)row * 512 + u.pn * 128 + wc * 32 + 8 * fq) = (unsigned long long)pk4_fp8(a[0], a[1], a[2], a[3]) | ((unsigned long long)pk4_fp8(b[0], b[1], b[2], b[3]) << 32);
        }
    }
    __device__ __forceinline__ void mid(f32x4 (&)[2][2][4][2], const Unit&, int, int, int, int) const {}
    __device__ __forceinline__ int vm_min(const Unit&) const { return 8; }
};
struct EpiDownF {
    static constexpr bool PERM = false, PERM16 = true;
    unsigned char* Y; const float* lw; LAS unsigned char* lds;
    __device__ __forceinline__ void operator()(const f32x4 (&acc)[2][2][4][2], const Unit& u, int wr, int wc, int fr, int fq) const {
        const int ebase = ((const LAS int*)(lds + MOE_LDS_BASE))[u.e], ecnt = ((const LAS int*)(lds + MOE_LDS_CNT))[u.e];
        PG8_FOR_ROWS(u) {
            const int row = u.orow0 + ai * HALF + wr * 64 + m * 16 + fr, pos = row - ebase; const float w = (u.kind == 0) ? (pos < ecnt ? 16.f * lw[(size_t)u.e * T + pos] : 0.f) : 16.f;
            u32x4 o;
            { const f32x4 a = acc[ai][0][m][0] * w, b = acc[ai][0][m][1] * w; o.x = pk4_fp8(a[0], a[1], a[2], a[3]); o.y = pk4_fp8(b[0], b[1], b[2], b[3]); }
            { const f32x4 a = acc[ai][1][m][0] * w, b = acc[ai][1][m][1] * w; o.z = pk4_fp8(a[0], a[1], a[2], a[3]); o.w = pk4_fp8(b[0], b[1], b[2], b[3]); }
            *(u32x4*)(Y + (size_t)row * 2048 + u.pn * BM + wc * 64 + 16 * fq) = o;
        }
    }
    __device__ __forceinline__ void mid(f32x4 (&)[2][2][4][2], const Unit&, int, int, int, int) const {}
    __device__ __forceinline__ int vm_min(const Unit&) const { return 8; }
};
}

struct EpiIn {
    bf16 *Q, *Kk, *V, *G, *CB, *UP, *GR, *GC; const float2* rot;
    __device__ __forceinline__ void operator()(int row, int col, float v) const {
        const float p1 = __shfl_xor(v, 1), p4 = __shfl_xor(v, 4);
        if (col < 2048) {
            const int f = (col & 127) >> 1, pos = row & (SEQ - 1);
            const float2 cs = rot[pos * 64 + f];
            const float o = (col & 1) ? (p1 * cs.y + v * cs.x) : (v * cs.x - p1 * cs.y);
            if (col < 1024) Q[(size_t)row * 1024 + col] = f2bf(o); else Kk[(size_t)row * 1024 + col - 1024] = f2bf(o);
        } else if (col < 3072) V[(size_t)row * 1024 + col - 2048] = f2bf(v);
        else if (col < 4096) G[(size_t)row * 1024 + col - 3072] = f2bf(silu_f(v));
        else if (col < 5120) CB[(size_t)row * 1024 + col - 4096] = f2bf(v);
        else if (col < 7168) { const int l = col - 5120; if ((l & 7) < 4) UP[(size_t)row * 1024 + (l >> 3) * 4 + (l & 3)] = f2bf(v * p4); }
        else if (col < 9216) GR[(size_t)row * 2048 + col - 7168] = f2bf(sigmoid_f(v));
        else GC[(size_t)row * 2048 + col - 9216] = f2bf(sigmoid_f(v));
    }
};
struct EpiMergeA { bf16* M; const bf16* GR; __device__ __forceinline__ void operator()(int row, int col, float v) const { const size_t i = (size_t)row * 2048 + col; M[i] = f2bf(bf2f(GR[i]) * v); } };
struct EpiMergeB { bf16* M; const bf16* GC; __device__ __forceinline__ void operator()(int row, int col, float v) const { const size_t i = (size_t)row * 2048 + col; M[i] = f2bf(bf2f(M[i]) + bf2f(GC[i]) * v); } };
struct EpiRes1 { const float* x; float* o; const float* mod; __device__ __forceinline__ void operator()(int row, int col, float v) const {
    const size_t i = (size_t)row * 2048 + col; const int b = row / SEQ; o[i] = x[i] + mod[b * 6 * D + 2 * D + col] * v; } };
struct EpiGU { bf16* ACT; __device__ __forceinline__ void operator()(int row, int col, float v) const {
    const float p4 = __shfl_xor(v, 4); if ((col & 7) < 4) ACT[(size_t)row * 512 + (col >> 3) * 4 + (col & 3)] = f2bf(silu_f(v) * p4); } };
struct EpiDown { bf16* Y; const float* rw; __device__ __forceinline__ void operator()(int row, int col, float v) const { Y[(size_t)row * 2048 + col] = f2bf(rw[row] * v); } };
struct EpiDownS { float* o; const float* mod; __device__ __forceinline__ void operator()(int row, int col, float v) const {
    const size_t i = (size_t)row * 2048 + col; const int b = row / SEQ; o[i] += mod[b * 6 * D + 5 * D + col] * v; } };

template <class Epi>
__device__ __forceinline__ void gemm_simple(const GemmS& g, int M, int N, LAS unsigned char* lds, const Epi& E, int bid, int nb) {
    const int tm = M / 128, tn = N / 256;
    for (int t = bid; t < tm * tn; t += nb) { const int pm = t / tn, pn = t % tn; gemm_tile_simple(g, pm * 128, pn * 256, lds, E); }
}

__device__ __forceinline__ float log_sigmoid_f(float x) { return -log1pf(expf(-x)); }
__device__ __forceinline__ bf16x8 frag_row(const LAS unsigned char* img, int r, int chunk) { return *(const LAS bf16x8*)(img + r * 256 + ((chunk ^ (r & 15)) << 4)); }
__device__ __forceinline__ bf16x8 frag_tr(const LAS unsigned char* img, int x, int chunk) { return *(const LAS bf16x8*)(img + x * 256 + ((chunk ^ ((x + (x >> 3)) & 15)) << 4)); }
__device__ __forceinline__ void stage_row_img(LAS unsigned char* img, const bf16* src, int ld) {
#pragma unroll
    for (int r = 0; r < 4; ++r) { const int p = threadIdx.x + NTHREADS * r, row = p >> 4, c = p & 15;
        const u32x4 v = *(const u32x4*)(src + (size_t)row * ld + c * 8);
        *(LAS u32x4*)(img + row * 256 + ((c ^ (row & 15)) << 4)) = v; }
}
__device__ __forceinline__ void stage_tr_img2(LAS unsigned char* img, const bf16* src, int ld) {
#pragma unroll 1
    for (int r = 0; r < 2; ++r) { const int p = threadIdx.x + NTHREADS * r, j = (p >> 4) * 2, c = p & 15;
        const u32x4 v0 = *(const u32x4*)(src + (size_t)j * ld + c * 8), v1 = *(const u32x4*)(src + (size_t)(j + 1) * ld + c * 8);
        const unsigned w0[4] = {v0.x, v0.y, v0.z, v0.w}, w1[4] = {v1.x, v1.y, v1.z, v1.w};
#pragma unroll
        for (int i = 0; i < 8; ++i) { const int x = 8 * c + i;
            const unsigned lo = (i & 1) ? (w0[i >> 1] >> 16) : (w0[i >> 1] & 0xffffu), hi = (i & 1) ? (w1[i >> 1] & 0xffff0000u) : (w1[i >> 1] << 16);
            *(LAS unsigned*)(img + x * 256 + (((j >> 3) ^ ((x + (x >> 3)) & 15)) << 4) + (j & 7) * 2) = lo | hi; }
    }
}
__device__ __forceinline__ void tile_load_row(const bf16* src, int ld, u32x4 (&v)[4]) {
#pragma unroll
    for (int r = 0; r < 4; ++r) { const int p = threadIdx.x + NTHREADS * r, row = p >> 4, c = p & 15; v[r] = *(const u32x4*)(src + (size_t)row * ld + c * 8); }
}
__device__ __forceinline__ void tile_store_row(LAS unsigned char* img, const u32x4 (&v)[4]) {
#pragma unroll
    for (int r = 0; r < 4; ++r) { const int p = threadIdx.x + NTHREADS * r, row = p >> 4, c = p & 15; *(LAS u32x4*)(img + row * 256 + ((c ^ (row & 15)) << 4)) = v[r]; }
}
__device__ __forceinline__ void tile_load_tr(const bf16* src, int ld, u32x4 (&v)[4]) {
#pragma unroll
    for (int r = 0; r < 2; ++r) { const int p = threadIdx.x + NTHREADS * r, j = (p >> 4) * 2, c = p & 15;
        v[2 * r] = *(const u32x4*)(src + (size_t)j * ld + c * 8); v[2 * r + 1] = *(const u32x4*)(src + (size_t)(j + 1) * ld + c * 8); }
}
__device__ __forceinline__ void tile_store_tr(LAS unsigned char* img, const u32x4 (&v)[4]) {
#pragma unroll
    for (int r = 0; r < 2; ++r) { const int p = threadIdx.x + NTHREADS * r, j = (p >> 4) * 2, c = p & 15;
        const u32x4 v0 = v[2 * r], v1 = v[2 * r + 1];
        const unsigned w0[4] = {v0.x, v0.y, v0.z, v0.w}, w1[4] = {v1.x, v1.y, v1.z, v1.w};
#pragma unroll
        for (int i = 0; i < 8; ++i) { const int x = 8 * c + i;
            const unsigned lo = (i & 1) ? (w0[i >> 1] >> 16) : (w0[i >> 1] & 0xffffu), hi = (i & 1) ? (w1[i >> 1] & 0xffff0000u) : (w1[i >> 1] << 16);
            *(LAS unsigned*)(img + x * 256 + (((j >> 3) ^ ((x + (x >> 3)) & 15)) << 4) + (j & 7) * 2) = lo | hi; }
    }
}
#define TILE_TIE(v) asm volatile("" : "+v"((v)[0]), "+v"((v)[1]), "+v"((v)[2]), "+v"((v)[3]))
__device__ __forceinline__ void ph_kv_conv(const Params& p, LAS unsigned char* lds, int bid, int nb) {
    unsigned char* ws = p.ws;
    const bf16* Kk = (const bf16*)(ws + WS_K); const bf16* V = (const bf16*)(ws + WS_V);
    const int lane = threadIdx.x & 63, w = threadIdx.x >> 6, r16 = lane & 15, q = lane >> 4;
    LAS unsigned char* TK = lds; LAS unsigned char* TV = lds + 32768;
#pragma unroll 1
    for (int item = bid; item < BATCH * NH * NCH; item += nb) {
        const int n = item % NCH, h = (item / NCH) % NH, b = item / (NCH * NH);
        const float lgf = log_sigmoid_f(p.dec_f[h]), lgb = log_sigmoid_f(p.dec_b[h]);
        const size_t row0 = (size_t)b * SEQ + n * CH;
        { u32x4 tk[4], tv[4]; tile_load_tr(Kk + row0 * 1024 + h * 128, 1024, tk); tile_load_tr(V + row0 * 1024 + h * 128, 1024, tv);
          asm volatile("" ::: "memory"); TILE_TIE(tk); TILE_TIE(tv); tile_store_tr(TK, tk); tile_store_tr(TV, tv); }
        lds_barrier();
        f32x4 af[8], ab[8];
#pragma unroll
        for (int d = 0; d < 8; ++d) { af[d] = (f32x4){0.f, 0.f, 0.f, 0.f}; ab[d] = (f32x4){0.f, 0.f, 0.f, 0.f}; }
#pragma unroll
        for (int ks = 0; ks < 4; ++ks) {
            union { bf16x8 v; unsigned u[4]; } raw, sf, sb; raw.v = frag_tr(TV, 16 * w + r16, 4 * ks + q);
            const int j0 = 32 * ks + 8 * q;
#pragma unroll
            for (int i = 0; i < 4; ++i) {
                const float lo = __uint_as_float(raw.u[i] << 16), hi = __uint_as_float(raw.u[i] & 0xffff0000u);
                const float wf0 = __expf(lgf * (float)(127 - (j0 + 2 * i))), wf1 = __expf(lgf * (float)(127 - (j0 + 2 * i + 1)));
                const float wb0 = __expf(lgb * (float)(j0 + 2 * i)), wb1 = __expf(lgb * (float)(j0 + 2 * i + 1));
                sf.u[i] = pg8::cvt_pk_bf16(lo * wf0, hi * wf1); sb.u[i] = pg8::cvt_pk_bf16(lo * wb0, hi * wb1);
            }
            const bf16x8 vf = sf.v, vb = sb.v;
#pragma unroll
            for (int d = 0; d < 8; ++d) { const bf16x8 a = frag_tr(TK, 16 * d + r16, 4 * ks + q);
                af[d] = __builtin_amdgcn_mfma_f32_16x16x32_bf16(a, vf, af[d], 0, 0, 0); ab[d] = __builtin_amdgcn_mfma_f32_16x16x32_bf16(a, vb, ab[d], 0, 0, 0); }
        }
        bf16* of = (bf16*)(ws + WS_KVF) + ((size_t)item * 128 + 16 * w + r16) * 128 + 4 * q;
        bf16* ob = (bf16*)(ws + WS_KVB) + ((size_t)item * 128 + 16 * w + r16) * 128 + 4 * q;
#pragma unroll
        for (int d = 0; d < 8; ++d) {
            *(unsigned long long*)(of + 16 * d) = (unsigned long long)pg8::cvt_pk_bf16(af[d][0], af[d][1]) | ((unsigned long long)pg8::cvt_pk_bf16(af[d][2], af[d][3]) << 32);
            *(unsigned long long*)(ob + 16 * d) = (unsigned long long)pg8::cvt_pk_bf16(ab[d][0], ab[d][1]) | ((unsigned long long)pg8::cvt_pk_bf16(ab[d][2], ab[d][3]) << 32);
        }
        lds_barrier();
    }
    const bf16* CB = (const bf16*)(ws + WS_CB); const bf16* UP = (const bf16*)(ws + WS_UP); bf16* ACAT = (bf16*)(ws + WS_ACAT);
    {
        const size_t i00 = (size_t)bid * NTHREADS + threadIdx.x, istride = (size_t)nb * NTHREADS, itotal = (size_t)T * DCONV / 8;
        const int c = (int)(i00 & 127) * 8;
        const f32x4 w0a = *(const f32x4*)(p.conv_w + c), w0b = *(const f32x4*)(p.conv_w + c + 4), w1a = *(const f32x4*)(p.conv_w + 1024 + c), w1b = *(const f32x4*)(p.conv_w + 1024 + c + 4),
                    w2a = *(const f32x4*)(p.conv_w + 2048 + c), w2b = *(const f32x4*)(p.conv_w + 2048 + c + 4);
        const u32x4 zero = (u32x4){0u, 0u, 0u, 0u};
        for (size_t ib = i00; ib < itotal; ib += 4 * istride) {
            u32x4 u0[4], u1[4], u2[4], cb[4];
#pragma unroll
            for (int q = 0; q < 4; ++q) { const size_t i = ib + q * istride; const bool ok = i < itotal; const size_t t = ok ? (i >> 7) : 0; const int pos = (int)(t & (SEQ - 1));
                u1[q] = *(const u32x4*)(UP + t * 1024 + c); cb[q] = *(const u32x4*)(CB + t * 1024 + c);
                u0[q] = pos > 0 ? *(const u32x4*)(UP + (t - 1) * 1024 + c) : zero; u2[q] = pos < SEQ - 1 ? *(const u32x4*)(UP + (t + 1) * 1024 + c) : zero; }
            asm volatile("" ::: "memory");
            asm volatile("" : "+v"(u0[0]), "+v"(u0[1]), "+v"(u0[2]), "+v"(u0[3]), "+v"(u1[0]), "+v"(u1[1]), "+v"(u1[2]), "+v"(u1[3]));
            asm volatile("" : "+v"(u2[0]), "+v"(u2[1]), "+v"(u2[2]), "+v"(u2[3]), "+v"(cb[0]), "+v"(cb[1]), "+v"(cb[2]), "+v"(cb[3]));
#pragma unroll
            for (int q = 0; q < 4; ++q) { const size_t i = ib + q * istride; if (i < itotal) { const size_t t = i >> 7;
                f32x4 a0, b0, a1, b1, a2, b2, ac, bc; pg8::unpack8(u0[q], a0, b0); pg8::unpack8(u1[q], a1, b1); pg8::unpack8(u2[q], a2, b2); pg8::unpack8(cb[q], ac, bc);
                const f32x4 ya = ac * (w0a * a0 + w1a * a1 + w2a * a2), yb = bc * (w0b * b0 + w1b * b1 + w2b * b2);
                *(u32x4*)(ACAT + t * 2048 + 1024 + c) = pg8::pack8(ya, yb); } }
        }
    }
}

__device__ __forceinline__ bf16x8 scale_frag(const bf16x8& f, float sc) {
    union { bf16x8 v; unsigned u[4]; } in, out; in.v = f;
#pragma unroll
    for (int i = 0; i < 4; ++i) out.u[i] = pg8::cvt_pk_bf16(__uint_as_float(in.u[i] << 16) * sc, __uint_as_float(in.u[i] & 0xffff0000u) * sc);
    return out.v;
}
__device__ __forceinline__ void ret_state_sum(const bf16* KV, int first, int count, float lg, bool fwd, LAS unsigned char* img) {
    f32x4 acc[4][2];
#pragma unroll
    for (int r = 0; r < 4; ++r) { acc[r][0] = (f32x4){0.f, 0.f, 0.f, 0.f}; acc[r][1] = (f32x4){0.f, 0.f, 0.f, 0.f}; }
    const float step = lg * 128.f;
    int maxd = (step < -1e-6f) ? (int)(-16.2f / step) : 1024;
    int m0 = 0, m1 = count;
    if (fwd) { if (count - 1 - maxd > 0) m0 = count - 1 - maxd; } else { if (maxd + 1 < count) m1 = maxd + 1; }
    const bf16* base = KV + (size_t)first * 128 * 128 + (size_t)threadIdx.x * 8;
    int m = m0;
    for (; m + 1 < m1; m += 2) {
        u32x4 v[2][4];
#pragma unroll
        for (int u = 0; u < 2; ++u)
#pragma unroll
            for (int r = 0; r < 4; ++r) v[u][r] = *(const u32x4*)(base + (size_t)(m + u) * 128 * 128 + NTHREADS * 8 * r);
#pragma unroll
        for (int u = 0; u < 2; ++u) { const float fac = __expf(step * (float)(fwd ? (count - 1 - (m + u)) : (m + u)));
#pragma unroll
            for (int r = 0; r < 4; ++r) { f32x4 a, b2; pg8::unpack8(v[u][r], a, b2); acc[r][0] += a * fac; acc[r][1] += b2 * fac; } }
    }
    if (m < m1) { const float fac = __expf(step * (float)(fwd ? (count - 1 - m) : m));
        u32x4 v[4];
#pragma unroll
        for (int r = 0; r < 4; ++r) v[r] = *(const u32x4*)(base + (size_t)m * 128 * 128 + NTHREADS * 8 * r);
#pragma unroll
        for (int r = 0; r < 4; ++r) { f32x4 a, b2; pg8::unpack8(v[r], a, b2); acc[r][0] += a * fac; acc[r][1] += b2 * fac; } }
#pragma unroll
    for (int r = 0; r < 4; ++r) { const int pidx = threadIdx.x + NTHREADS * r, e = pidx >> 4, c = pidx & 15;
        *(LAS u32x4*)(img + e * 256 + ((c ^ (e & 15)) << 4)) = pg8::pack8(acc[r][0], acc[r][1]); }
}
__device__ __forceinline__ void ph_ret_out(const Params& p, LAS unsigned char* lds, int bid, int nb) {
    unsigned char* ws = p.ws;
    const bf16* Q = (const bf16*)(ws + WS_Q); const bf16* Kk = (const bf16*)(ws + WS_K); const bf16* V = (const bf16*)(ws + WS_V); const bf16* G = (const bf16*)(ws + WS_G);
    const bf16* KVF = (const bf16*)(ws + WS_KVF); const bf16* KVB = (const bf16*)(ws + WS_KVB); bf16* ACAT = (bf16*)(ws + WS_ACAT);
    const int lane = threadIdx.x & 63, w = threadIdx.x >> 6, r16_ = lane & 15, q_ = lane >> 4;
    LAS unsigned char* QI = lds; LAS unsigned char* KI = lds + 32768; LAS unsigned char* TV = lds + 65536; LAS unsigned char* PI = lds + 98304;
    u32x4 tq[4], tk[4], tv[4];
    if (bid < BATCH * NH * NCH) { const int n = bid % NCH, b = bid / (NCH * NH), h = (bid / NCH) % NH; const size_t row0 = (size_t)b * SEQ + n * CH;
        tile_load_row(Q + row0 * 1024 + h * 128, 1024, tq); tile_load_row(Kk + row0 * 1024 + h * 128, 1024, tk); tile_load_tr(V + row0 * 1024 + h * 128, 1024, tv); }
#pragma unroll 1
    for (int item = bid; item < BATCH * NH * NCH; item += nb) {
        const int n = item % NCH, b = item / (NCH * NH), h = ((item / NCH) + item / nb) % NH, it2 = (b * NH + h) * NCH + n;
        const float lgf = log_sigmoid_f(p.dec_f[h]), lgb = log_sigmoid_f(p.dec_b[h]);
        const size_t row0 = (size_t)b * SEQ + n * CH;
        asm volatile("" ::: "memory"); TILE_TIE(tq); TILE_TIE(tk); TILE_TIE(tv); tile_store_row(QI, tq); tile_store_row(KI, tk); tile_store_tr(TV, tv);
        if (item + nb < BATCH * NH * NCH) { const int it1 = item + nb, n1 = it1 % NCH, b1 = it1 / (NCH * NH), h1 = ((it1 / NCH) + it1 / nb) % NH; const size_t r1 = (size_t)b1 * SEQ + n1 * CH;
            tile_load_row(Q + r1 * 1024 + h1 * 128, 1024, tq); tile_load_row(Kk + r1 * 1024 + h1 * 128, 1024, tk); tile_load_tr(V + r1 * 1024 + h1 * 128, 1024, tv); }
        asm volatile("" ::: "memory");
        lds_barrier();
        int r16 = r16_, q = q_;
        asm volatile("" : "+v"(r16), "+v"(q));
        int iq = 16 * w + r16;
        asm volatile("" : "+v"(iq));
#pragma unroll
        for (int jb = 0; jb < 8; ++jb) {
            f32x4 sacc = (f32x4){0.f, 0.f, 0.f, 0.f};
#pragma unroll
            for (int ks = 0; ks < 4; ++ks) sacc = __builtin_amdgcn_mfma_f32_16x16x32_bf16(frag_row(KI, 16 * jb + r16, 4 * ks + q), frag_row(QI, iq, 4 * ks + q), sacc, 0, 0, 0);
            float pv[4];
#pragma unroll
            for (int rr = 0; rr < 4; ++rr) { const int jj = 16 * jb + 4 * q + rr; const float df = (float)(iq - jj);
                pv[rr] = sacc[rr] * ((iq >= jj) ? __expf(lgf * df) : __expf(-lgb * df)); }
            *(LAS unsigned long long*)(PI + iq * 256 + (((2 * jb + (q >> 1)) ^ (iq & 15)) << 4) + (q & 1) * 8) =
                (unsigned long long)pg8::cvt_pk_bf16(pv[0], pv[1]) | ((unsigned long long)pg8::cvt_pk_bf16(pv[2], pv[3]) << 32);
        }
        lds_barrier();
        ret_state_sum(KVF, it2 - n, n, lgf, true, KI);
        lds_barrier();
        f32x4 o1[8];
#pragma unroll
        for (int e = 0; e < 8; ++e) o1[e] = (f32x4){0.f, 0.f, 0.f, 0.f};
        {
            const float sf = __expf(lgf * (float)(iq + 1));
#pragma unroll
            for (int ks = 0; ks < 4; ++ks) {
                const bf16x8 pf = frag_row(PI, iq, 4 * ks + q), qs = scale_frag(frag_row(QI, iq, 4 * ks + q), sf);
#pragma unroll
                for (int e = 0; e < 8; ++e) { o1[e] = __builtin_amdgcn_mfma_f32_16x16x32_bf16(frag_tr(TV, 16 * e + r16, 4 * ks + q), pf, o1[e], 0, 0, 0);
                    o1[e] = __builtin_amdgcn_mfma_f32_16x16x32_bf16(frag_row(KI, 16 * e + r16, 4 * ks + q), qs, o1[e], 0, 0, 0); }
            }
        }
        lds_barrier();
        ret_state_sum(KVB, it2 + 1, NCH - 1 - n, lgb, false, TV);
        lds_barrier();
        {
            const float sb = __expf(lgb * (float)(128 - iq));
#pragma unroll
            for (int ks = 0; ks < 4; ++ks) {
                const bf16x8 qs = scale_frag(frag_row(QI, iq, 4 * ks + q), sb);
#pragma unroll
                for (int e = 0; e < 8; ++e) o1[e] = __builtin_amdgcn_mfma_f32_16x16x32_bf16(frag_row(TV, 16 * e + r16, 4 * ks + q), qs, o1[e], 0, 0, 0);
            }
        }
        float ss = 0.f;
#pragma unroll
        for (int e = 0; e < 8; ++e) ss += (o1[e][0] * o1[e][0] + o1[e][1] * o1[e][1]) + (o1[e][2] * o1[e][2] + o1[e][3] * o1[e][3]);
        ss += __shfl_xor(ss, 16); ss += __shfl_xor(ss, 32);
        const float rstd = rsqrtf(ss * (1.f / 128.f) + EPS);
#pragma unroll
        for (int e = 0; e < 8; ++e) { const int col = h * 128 + 16 * e + 4 * q;
            const unsigned long long gq = *(const unsigned long long*)(G + (row0 + iq) * 1024 + col);
            const f32x4 wv = *(const f32x4*)(p.ret_norm_w + col);
            const float g0 = __uint_as_float((unsigned)(gq & 0xffffull) << 16), g1 = __uint_as_float((unsigned)((gq >> 16) & 0xffffull) << 16),
                        g2 = __uint_as_float((unsigned)((gq >> 32) & 0xffffull) << 16), g3 = __uint_as_float((unsigned)(gq >> 48) << 16);
            *(unsigned long long*)(ACAT + (row0 + iq) * 2048 + col) = (unsigned long long)pg8::cvt_pk_bf16(g0 * o1[e][0] * rstd * wv[0], g1 * o1[e][1] * rstd * wv[1]) |
                ((unsigned long long)pg8::cvt_pk_bf16(g2 * o1[e][2] * rstd * wv[2], g3 * o1[e][3] * rstd * wv[3]) << 32); }
        lds_barrier();
    }
}

__device__ __forceinline__ void ph_norm2_route(const float* x1, const float* norm2_w, const float* router_w, const float* router_b, unsigned char* ws, LAS unsigned char* lds, int bid, int nb) {
    int tidl = threadIdx.x; asm volatile("" : "+v"(tidl));
    const int lane = tidl & 63, wave = tidl >> 6, r16 = lane & 15, kq = lane >> 4;
    const float* mod = (const float*)(ws + WS_MOD);
    bf16* H = (bf16*)(ws + WS_H);
    unsigned* ctl = (unsigned*)(ws + WS_CTL);
    int* selE = (int*)(ws + WS_SELE); float* selW = (float*)(ws + WS_SELW); int* selP = (int*)(ws + WS_SELP);
    constexpr int PITCH = 2052;
    LAS float* hrow = (LAS float*)lds;
    LAS float* part = (LAS float*)lds;
    LAS int* lcnt = (LAS int*)(lds + 16 * PITCH * 4);
    if (threadIdx.x < 128) lcnt[threadIdx.x] = 0;
    __syncthreads();
    const bf16* WH = (const bf16*)(ws + WS_RWH); const bf16* WL = (const bf16*)(ws + WS_RWL);
    f32x4 wn[8];
#pragma unroll
    for (int j = 0; j < 8; ++j) wn[j] = *(const f32x4*)(norm2_w + 4 * lane + 256 * j);
    const float rbias = router_b[lane];
    f32x4 va[2][8];
    if (bid < T / 16) {
#pragma unroll
        for (int rr = 0; rr < 2; ++rr)
#pragma unroll
            for (int j = 0; j < 8; ++j) va[rr][j] = ((const f32x4*)(x1 + (size_t)(bid * 16 + 2 * wave + rr) * D) + lane)[64 * j];
    }
    for (int g = bid; g < T / 16; g += nb) {
        const int r0 = g * 16;
        f32x4 sh[8], sc[8];
        { const int b = r0 / SEQ;
#pragma unroll
          for (int j = 0; j < 8; ++j) { sh[j] = *(const f32x4*)(mod + b * 6 * D + 3 * D + 4 * lane + 256 * j); sc[j] = *(const f32x4*)(mod + b * 6 * D + 4 * D + 4 * lane + 256 * j); } }
        asm volatile("" ::: "memory");
        asm volatile("" : "+v"(sh[0]), "+v"(sh[1]), "+v"(sh[2]), "+v"(sh[3]), "+v"(sh[4]), "+v"(sh[5]), "+v"(sh[6]), "+v"(sh[7]));
        asm volatile("" : "+v"(sc[0]), "+v"(sc[1]), "+v"(sc[2]), "+v"(sc[3]), "+v"(sc[4]), "+v"(sc[5]), "+v"(sc[6]), "+v"(sc[7]));
#pragma unroll
        for (int rr = 0; rr < 2; ++rr) {
            const int rl = 2 * wave + rr, row = r0 + rl; float ss = 0.f;
#pragma unroll
            for (int j = 0; j < 8; ++j) ss += (va[rr][j].x * va[rr][j].x + va[rr][j].y * va[rr][j].y) + (va[rr][j].z * va[rr][j].z + va[rr][j].w * va[rr][j].w);
            const float rstd = rsqrtf(wave_sum(ss) * (1.f / D) + EPS);
#pragma unroll
            for (int j = 0; j < 8; ++j) {
                const int col = 4 * lane + 256 * j;
                const f32x4 y = va[rr][j] * rstd * wn[j] * (sc[j] + 1.0f) + sh[j];
                *(unsigned*)((unsigned char*)H + (size_t)row * D + col) = pk4_fp8(y.x, y.y, y.z, y.w);
                *(LAS f32x4*)(hrow + rl * PITCH + col) = y;
            }
        }
        lds_barrier();
        f32x4 acc[4];
#pragma unroll
        for (int e = 0; e < 4; ++e) acc[e] = (f32x4){0.f, 0.f, 0.f, 0.f};
        const LAS float* ap = hrow + r16 * PITCH + 256 * wave + 8 * kq;
        const size_t bo = ((size_t)wave * 8 * 4 * 64 + lane) * 8;
        bf16x8 bh0[4], bl0[4], bh1[4], bl1[4];
#define RT_LOADB(BH, BL, KS) do { _Pragma("unroll") for (int eb = 0; eb < 4; ++eb) { BH[eb] = *(const bf16x8*)(WH + bo + (size_t)((KS) * 4 + eb) * 512); BL[eb] = *(const bf16x8*)(WL + bo + (size_t)((KS) * 4 + eb) * 512); } } while (0)
#define RT_STEP(BH, BL, KS) do { const f32x4 a0 = *(const LAS f32x4*)(ap + 32 * (KS)), a1 = *(const LAS f32x4*)(ap + 32 * (KS) + 4); \
            u32x4 hw = pg8::pack8(a0, a1); f32x4 h0, h1; pg8::unpack8(hw, h0, h1); const u32x4 lw = pg8::pack8(a0 - h0, a1 - h1); \
            const bf16x8 ah = __builtin_bit_cast(bf16x8, hw), al = __builtin_bit_cast(bf16x8, lw); \
            _Pragma("unroll") for (int eb = 0; eb < 4; ++eb) { acc[eb] = __builtin_amdgcn_mfma_f32_16x16x32_bf16(ah, BH[eb], acc[eb], 0, 0, 0); \
                acc[eb] = __builtin_amdgcn_mfma_f32_16x16x32_bf16(al, BH[eb], acc[eb], 0, 0, 0); acc[eb] = __builtin_amdgcn_mfma_f32_16x16x32_bf16(ah, BL[eb], acc[eb], 0, 0, 0); } } while (0)
        RT_LOADB(bh0, bl0, 0);
#pragma unroll 1
        for (int ks = 0; ks < 8; ks += 2) {
            RT_LOADB(bh1, bl1, ks + 1);
            asm volatile("" ::: "memory");
            RT_STEP(bh0, bl0, ks);
            if (ks + 2 < 8) RT_LOADB(bh0, bl0, ks + 2);
            asm volatile("" ::: "memory");
            RT_STEP(bh1, bl1, ks + 1);
        }
#undef RT_LOADB
#undef RT_STEP
        if (g + nb < T / 16) {
#pragma unroll
            for (int rr = 0; rr < 2; ++rr)
#pragma unroll
                for (int j = 0; j < 8; ++j) va[rr][j] = ((const f32x4*)(x1 + (size_t)((g + nb) * 16 + 2 * wave + rr) * D) + lane)[64 * j];
        }
        lds_barrier();
#pragma unroll
        for (int rr = 0; rr < 4; ++rr) *(LAS f32x4*)(part + (wave * 16 + 4 * kq + rr) * 64 + 4 * r16) = (f32x4){acc[0][rr], acc[1][rr], acc[2][rr], acc[3][rr]};
        lds_barrier();
#pragma unroll 1
        for (int rr = 0; rr < 2; ++rr) {
            const int rl = 2 * wave + rr, row = r0 + rl;
            float lg = 0.f;
#pragma unroll
            for (int w8 = 0; w8 < 8; ++w8) lg += part[(w8 * 16 + rl) * 64 + lane];
            if (!(fabsf(lg) < 1e30f)) lg = 0.f;
            const float score = sigmoid_f(lg), biased = score + rbias;
            float m1 = biased;
            m1 = fmaxf(m1, __shfl_xor(m1, 1)); m1 = fmaxf(m1, __shfl_xor(m1, 2)); m1 = fmaxf(m1, __shfl_xor(m1, 4));
            const unsigned long long eq = __ballot(biased == m1);
            const int gbase = lane & ~7;
            const unsigned geq = (unsigned)((eq >> gbase) & 0xffull);
            const int first = gbase + __builtin_ctz(geq | 0x100u);
            float m2 = (lane == first) ? -INFINITY : biased;
            m2 = fmaxf(m2, __shfl_xor(m2, 1)); m2 = fmaxf(m2, __shfl_xor(m2, 2)); m2 = fmaxf(m2, __shfl_xor(m2, 4));
            const float gs = m1 + m2;
            const int gi = lane >> 3; int grank = 0;
#pragma unroll
            for (int gg = 0; gg < 8; ++gg) { const float o = __shfl(gs, gg * 8); grank += (o > gs || (o == gs && gg < gi)) ? 1 : 0; }
            const float masked = (grank < 4) ? biased : -INFINITY;
            int rank = 0;
#pragma unroll 8
            for (int e = 0; e < 64; ++e) { const float o = __shfl(masked, e); rank += (o > masked || (o == masked && e < lane)) ? 1 : 0; }
            const bool sel = rank < TOPK;
            const float ssum = wave_sum(sel ? score : 0.f);
            if (sel) {
                const int pos = __hip_atomic_fetch_add(&lcnt[lane], 1, __ATOMIC_RELAXED, __HIP_MEMORY_SCOPE_WORKGROUP);
                selE[row * 8 + rank] = lane; selW[row * 8 + rank] = score / ssum * ROUTED_SCALE; selP[row * 8 + rank] = pos;
            }
        }
        lds_barrier();
    }
    asm volatile("s_waitcnt vmcnt(0)" ::: "memory");
    __syncthreads();
    if (threadIdx.x < 64) lcnt[64 + threadIdx.x] = (int)atomicAdd(&ctl[CW_CNT + 64 * threadIdx.x], (unsigned)lcnt[threadIdx.x]);
    __syncthreads();
    for (int g = bid; g < T / 16; g += nb)
        for (int i = threadIdx.x; i < 128; i += NTHREADS) { const int idx = g * 128 + i, e = selE[idx], pos = selP[idx] + lcnt[64 + e]; selP[idx] = pos;
            ((int*)(ws + WS_LTOK))[(size_t)e * T + pos] = idx >> 3; ((float*)(ws + WS_LW))[(size_t)e * T + pos] = selW[idx]; }
}
__device__ __forceinline__ void ph_scatter(const Params& p, LAS unsigned char* lds, int bid, int nb) {
    unsigned char* ws = p.ws; unsigned* ctl = (unsigned*)(ws + WS_CTL);
    const int* selE = (const int*)(ws + WS_SELE); const float* selW = (const float*)(ws + WS_SELW); const int* selP = (const int*)(ws + WS_SELP);
    int* prow = (int*)(ws + WS_PROW); int* rtok = (int*)(ws + WS_RTOK); float* rw = (float*)(ws + WS_RW);
    LAS int* sbase = (LAS int*)lds; LAS int* scnt = (LAS int*)(lds + 512);
    if (threadIdx.x < 64) {
        const int e = threadIdx.x, c = (int)ctl[CW_CNT + 64 * e], pad = (c + 255) & ~255;
        int incl = pad;
#pragma unroll
        for (int o = 1; o < 64; o <<= 1) { const int v = __shfl_up(incl, o); if (e >= o) incl += v; }
        sbase[e] = incl - pad; scnt[e] = c; if (e == 63) sbase[64] = incl;
        if (bid == 0) { ctl[CW_BASE + e] = (unsigned)(incl - pad); if (e == 63) ctl[CW_BASE + 64] = (unsigned)incl; }
    }
    __syncthreads();
    for (int i = bid * NTHREADS + threadIdx.x; i < T * TOPK; i += nb * NTHREADS) {
        const int e = selE[i], r = sbase[e] + selP[i];
        prow[i] = r; rtok[r] = i >> 3; rw[r] = selW[i];
    }
    for (int e = bid; e < NE; e += nb) { const int lo = sbase[e] + scnt[e], hi = sbase[e + 1];
        for (int r = lo + threadIdx.x; r < hi; r += NTHREADS) { rtok[r] = 0; rw[r] = 0.f; } }
}
__device__ __forceinline__ int expert_of_row(const unsigned* ctl, int row) { int e = 0; while (e < NE - 1 && (int)ctl[CW_BASE + e + 1] <= row) ++e; return e; }
__device__ __forceinline__ void ph_moe_gu(const Params& p, LAS unsigned char* lds, int bid, int nb) {
    unsigned char* ws = p.ws; const unsigned* ctl = (const unsigned*)(ws + WS_CTL);
    const int rows = (int)ctl[CW_BASE + NE], tm = rows / 128, tn = 1024 / 256;
    EpiGU E{(bf16*)(ws + WS_ACT)};
    for (int t = bid; t < tm * tn; t += nb) { const int pm = t / tn, pn = t % tn; const int e = expert_of_row(ctl, pm * 128);
        GemmS g{(const bf16*)(ws + WS_H), D, (const int*)(ws + WS_RTOK), (const bf16*)(ws + WS_WGU) + (size_t)e * 1024 * D, D, D};
        gemm_tile_simple(g, pm * 128, pn * 256, lds, E); }
    GemmS gs{(const bf16*)(ws + WS_H), D, nullptr, (const bf16*)(ws + WS_WSGU), D, D};
    EpiGU Es{(bf16*)(ws + WS_ACTS)};
    gemm_simple(gs, T, 1024, lds, Es, bid, nb);
}
__device__ __forceinline__ void ph_moe_down(const Params& p, LAS unsigned char* lds, int bid, int nb) {
    unsigned char* ws = p.ws; const unsigned* ctl = (const unsigned*)(ws + WS_CTL);
    const int rows = (int)ctl[CW_BASE + NE], tm = rows / 128, tn = 2048 / 256;
    EpiDown E{(bf16*)(ws + WS_Y), (const float*)(ws + WS_RW)};
    for (int t = bid; t < tm * tn; t += nb) { const int pm = t / tn, pn = t % tn; const int e = expert_of_row(ctl, pm * 128);
        GemmS g{(const bf16*)(ws + WS_ACT), DEXP, nullptr, (const bf16*)(ws + WS_WD) + (size_t)e * D * DEXP, DEXP, DEXP};
        gemm_tile_simple(g, pm * 128, pn * 256, lds, E); }
    GemmS gs{(const bf16*)(ws + WS_ACTS), DSH, nullptr, (const bf16*)(ws + WS_WSD), DSH, DSH};
    EpiDownS Es{p.out, (const float*)(ws + WS_MOD)};
    gemm_simple(gs, T, 2048, lds, Es, bid, nb);
}
typedef float f32x2c __attribute__((ext_vector_type(2)));
__device__ __attribute__((noinline)) void ph_combine(float* pout_, const float* final_w_, unsigned char* ws_, LAS unsigned char* lds, int bid, int nb) {
    float GAS* pout = (float GAS*)pout_; const float GAS* final_w = (const float GAS*)final_w_; unsigned char GAS* ws = (unsigned char GAS*)ws_;
    const int lane = threadIdx.x & 63, wave = threadIdx.x >> 6; const float GAS* mod = (const float GAS*)(ws + WS_MOD); const unsigned char GAS* Y = ws + WS_Y;
    const int GAS* selE = (const int GAS*)(ws + WS_SELE); const int GAS* selP = (const int GAS*)(ws + WS_SELP);
    *(LAS f32x4*)(lds + 16 * threadIdx.x) = *(const f32x4 GAS*)(final_w + 4 * threadIdx.x);
    (void)pg8::moe_base_tables((const unsigned*)(ws_ + WS_CTL), lds); const LAS int* ebase = (const LAS int*)(lds + pg8::MOE_LDS_BASE);
    for (int row = bid * 8 + wave; row < T; row += nb * 8) {
        const int b = row / SEQ;
        int pr[8], se[8], sp[8];
#pragma unroll
        for (int k = 0; k < 8; ++k) { se[k] = selE[row * 8 + k]; sp[k] = selP[row * 8 + k]; }
        asm volatile("" ::: "memory");
#pragma unroll
        for (int k = 0; k < 8; ++k) pr[k] = __builtin_amdgcn_readfirstlane(ebase[se[k]] + sp[k]);
        asm volatile("" ::: "memory");
        f32x4 v[2][4]; float s = 0.f;
#pragma unroll
        for (int j = 0; j < 2; ++j) {
            const int col = 16 * lane + 1024 * j;
            u32x4 y[9]; f32x4 xv[4], gv[4];
#pragma unroll
            for (int k = 0; k < 8; ++k) y[k] = __builtin_nontemporal_load((const u32x4 GAS*)(Y + (size_t)pr[k] * 2048 + col));
            y[8] = __builtin_nontemporal_load((const u32x4 GAS*)(Y + (size_t)(CAP + row) * 2048 + col));
            const float GAS* xr = pout + (size_t)row * D + col; const float GAS* gr = mod + b * 6 * D + 5 * D + col;
#pragma unroll
            for (int d = 0; d < 4; ++d) { xv[d] = *(const f32x4 GAS*)(xr + 4 * d); gv[d] = *(const f32x4 GAS*)(gr + 4 * d); }
            asm volatile("" ::: "memory");
            asm volatile("" : "+v"(y[0]), "+v"(y[1]), "+v"(y[2]), "+v"(y[3]), "+v"(y[4]), "+v"(y[5]), "+v"(y[6]), "+v"(y[7]), "+v"(y[8]));
            asm volatile("" : "+v"(xv[0]), "+v"(xv[1]), "+v"(xv[2]), "+v"(xv[3]), "+v"(gv[0]), "+v"(gv[1]), "+v"(gv[2]), "+v"(gv[3]));
            float a[16];
#pragma unroll
            for (int i = 0; i < 16; ++i) a[i] = 0.f;
#pragma unroll
            for (int k = 0; k < 9; ++k) { const unsigned w[4] = {y[k].x, y[k].y, y[k].z, y[k].w};
#pragma unroll
                for (int d = 0; d < 4; ++d) { const f32x2c lo = __builtin_amdgcn_cvt_pk_f32_fp8((int)w[d], false), hi = __builtin_amdgcn_cvt_pk_f32_fp8((int)w[d], true);
                    a[4 * d] += lo[0]; a[4 * d + 1] += lo[1]; a[4 * d + 2] += hi[0]; a[4 * d + 3] += hi[1]; } }
#pragma unroll
            for (int d = 0; d < 4; ++d) { const f32x4 av = (f32x4){a[4 * d], a[4 * d + 1], a[4 * d + 2], a[4 * d + 3]} * 0.0625f;
                v[j][d] = xv[d] + gv[d] * av;
                s += (v[j][d].x * v[j][d].x + v[j][d].y * v[j][d].y) + (v[j][d].z * v[j][d].z + v[j][d].w * v[j][d].w); }
        }
        const float rstd = rsqrtf(wave_sum(s) * (1.f / D) + EPS);
#pragma unroll
        for (int j = 0; j < 2; ++j) { const int col = 16 * lane + 1024 * j; float GAS* o = pout + (size_t)row * D + col;
#pragma unroll
            for (int d = 0; d < 4; ++d) *(f32x4 GAS*)(o + 4 * d) = v[j][d] * rstd * *(const LAS f32x4*)(lds + 4 * (col + 4 * d)); }
    }
}

#define XB_TMO      128
#define XB_XCNT(j)  (256  + 64 * (j))
#define XB_XSUB(j)  (1280 + 64 * (j))
#define XB_XGEN(j)  (2304 + 64 * (j))
#define XB_TOP      3328
#define XB_TOPGEN   3392
#define XCD_BAR_WORDS 3456
#define XB_SPIN_CAP (1u << 18)
__device__ __forceinline__ unsigned xb_ld(unsigned* p)              { return __hip_atomic_load(p, __ATOMIC_RELAXED, __HIP_MEMORY_SCOPE_AGENT); }
__device__ __forceinline__ unsigned xb_add(unsigned* p, unsigned v) { return __hip_atomic_fetch_add(p, v, __ATOMIC_RELAXED, __HIP_MEMORY_SCOPE_AGENT); }
__device__ __forceinline__ unsigned xb_xcc_id() { return (unsigned)__builtin_amdgcn_s_getreg((3 << 11) | 20) & 0xFu; }
#define XB_SPIN(cond, bar) do { unsigned _sp = 0; while (cond) { __builtin_amdgcn_s_sleep(1); \
    if ((++_sp & 255u) == 0u) { if (xb_ld(&(bar)[XB_TMO])) break; if (_sp > XB_SPIN_CAP) { atomicAdd(&(bar)[XB_TMO], 1u); break; } } } } while (0)
struct XcdBarrier { unsigned* bar; unsigned x; volatile LAS unsigned* st; };
__device__ __forceinline__ XcdBarrier xcd_barrier_post(unsigned* bar, volatile LAS unsigned* st) {
    XcdBarrier b; b.bar = bar; b.x = xb_xcc_id(); b.st = st;
    if (threadIdx.x == 0) (void)xb_add(&bar[XB_XCNT(b.x)], 1u);
    return b;
}
__device__ __forceinline__ void xcd_barrier_complete(unsigned* bar, unsigned x, unsigned& nloc, unsigned& nx) {
    const unsigned G = gridDim.x * gridDim.y * gridDim.z;
    unsigned sum, cnt, mine, sp = 0u;
    for (;;) {
        sum = 0u; cnt = 0u; mine = 0u;
#pragma unroll
        for (unsigned j = 0; j < 16; ++j) { const unsigned c = xb_ld(&bar[XB_XCNT(j)]); sum += c; cnt += (c > 0u) ? 1u : 0u; mine = (j == x) ? c : mine; }
        if (sum == G) break;
        __builtin_amdgcn_s_sleep(1);
        if ((++sp & 255u) == 0u) { if (xb_ld(&bar[XB_TMO])) break; if (sp > XB_SPIN_CAP) { atomicAdd(&bar[XB_TMO], 1u); break; } }
    }
    nloc = mine > 0u ? mine : 1u; nx = cnt > 0u ? cnt : 1u;
}
__device__ __forceinline__ void xcd_barrier(const XcdBarrier& b) {
    asm volatile("s_waitcnt vmcnt(0)" ::: "memory");
    __syncthreads();
    if (threadIdx.x == 0) {
        unsigned* bar = b.bar;
        __builtin_amdgcn_s_waitcnt(0);
        unsigned nloc = b.st[0], nx = b.st[1];
        if (nloc == 0u) { xcd_barrier_complete(bar, b.x, nloc, nx); b.st[0] = nloc; b.st[1] = nx; }
        const unsigned old = xb_add(&bar[XB_XSUB(b.x)], 1u);
        const unsigned gen = old / nloc;
        if (old + 1u == (gen + 1u) * nloc) {
            __builtin_amdgcn_fence(__ATOMIC_RELEASE, "agent");
            asm volatile("s_waitcnt vmcnt(0)" ::: "memory");
            const unsigned og = xb_add(&bar[XB_TOP], 1u);
            const unsigned tg = og / nx;
            if (og + 1u == (tg + 1u) * nx) xb_add(&bar[XB_TOPGEN], 1u);
            else XB_SPIN(xb_ld(&bar[XB_TOPGEN]) == tg, bar);
            __builtin_amdgcn_fence(__ATOMIC_ACQUIRE, "agent");
            xb_add(&bar[XB_XGEN(b.x)], 1u);
            asm volatile("s_waitcnt vmcnt(0)" ::: "memory");
        } else {
            XB_SPIN(xb_ld(&bar[XB_XGEN(b.x)]) == gen, bar);
            __builtin_amdgcn_fence(__ATOMIC_ACQUIRE, "agent");
            asm volatile("s_waitcnt vmcnt(0)" ::: "memory");
        }
    }
    __syncthreads();
}
constexpr int CW_BAR = 4096;

constexpr int NPH = 15;
__global__ void __launch_bounds__(NTHREADS, 2) mk(Params p) {
    extern __shared__ __attribute__((aligned(16))) unsigned char lds_raw[];
    LAS unsigned char* lds = (LAS unsigned char*)lds_raw;
    const int bid = blockIdx.x, nb = gridDim.x;
    volatile LAS unsigned* xbw = (volatile LAS unsigned*)(lds + LDS_BYTES - 16);
    if (threadIdx.x == 0) { xbw[0] = 0u; xbw[1] = 0u; xbw[2] = 0u; xbw[3] = 0u; }
    __syncthreads();
    XcdBarrier bar = xcd_barrier_post((unsigned*)(p.ws + WS_CTL) + CW_BAR, xbw);
#ifndef ONLYMASK
#define ONLYMASK 0x7fff
#endif
#define IN(k) ((ONLYMASK >> (k)) & 1)
#define LOADP() do {} while (0)
#define SEAM(k) do { if (IN(k) && IN((k) + 1)) xcd_barrier(bar); } while (0)
    if (IN(0)) { LOADP(); ph_adaln(p, lds, bid, nb); }
    if (IN(1)) { LOADP(); ph_convert(p, lds, xbw + 2); }
    SEAM(1);
    if (IN(2)) { LOADP(); ph_norm1(p, bid, nb); }
    SEAM(2);
    if (IN(3)) { LOADP(); unsigned char* ws = p.ws;
        pg8::DenseSched S{(const bf16*)(ws + WS_H), 2 * D, (const bf16*)(ws + WS_WIN), 2 * D, 2 * D, T / 256, 7168 / 256, nb, bid};
        pg8::EpiInF E{ws, 0};
        typedef pg8::DenseSched8<127, 121> SchedG8;
        SchedG8 S8{{(const bf16*)(ws + WS_H8A), D, (const bf16*)(ws + WS_WIN8), D, D, T / 256, 4096 / 256, nb, bid}};
        pg8::EpiInF E8{ws, 28};
        const int grp = (bid >> 3) & 3;
        for (int part = 0; part < 2; ++part) {
            S8.i0 = part ? grp : 0; S8.i1 = part ? (1 << 30) : grp;
            pg8::gemm_phase<pg8::EpiInF, SchedG8, true, false, true>(lds, S8, E8, -1);
            if (part == 0) pg8::gemm_phase<pg8::EpiInF, pg8::DenseSched, true, false>(lds, S, E, -1);
        }
    }
    SEAM(3);
    if (IN(4)) { LOADP(); ph_kv_conv(p, lds, bid, nb); }
    SEAM(4);
    if (IN(5)) { LOADP(); ph_ret_out(p, lds, bid, nb); }
    SEAM(5);
    if (IN(6)) { LOADP(); unsigned char* ws = p.ws;
        pg8::DenseSched S{(const bf16*)(ws + WS_ACAT), 4096, (const bf16*)(ws + WS_WRC), 4096, 4096, T / 256, D / 256, nb, bid};
        pg8::EpiMergeF E{(bf16*)(ws + WS_MERGED), (const bf16*)(ws + WS_GR), (const bf16*)(ws + WS_GC)};
        pg8::gemm_phase<pg8::EpiMergeF, pg8::DenseSched, true, true>(lds, S, E, 16);
    }
    SEAM(6);
    if (IN(8)) { LOADP(); unsigned char* ws = p.ws;
        pg8::DenseSched S{(const bf16*)(ws + WS_MERGED), 4096, (const bf16*)(ws + WS_WOUT), 4096, 4096, T / 256, D / 256, nb, bid};
        pg8::EpiRes1F E{p.x, p.out, (const float*)(ws + WS_MOD)};
        pg8::gemm_phase<pg8::EpiRes1F, pg8::DenseSched, true, false>(lds, S, E, -1);
    }
    SEAM(8);
    if (IN(9)) { LOADP(); ph_norm2_route(p.out, p.norm2_w, p.router_w, p.router_b, p.ws, lds, bid, nb); }
    SEAM(9);
    if (IN(12)) { LOADP(); unsigned char* ws = p.ws;
        const unsigned* ctl = (const unsigned*)(ws + WS_CTL);
        const int total_rt = pg8::moe_base_tables(ctl, lds) / 256;
        typedef pg8::MoeSched<true, true, 127, 121> SchedGU;
        SchedGU S{(const bf16*)(ws + WS_H), D, D, D, total_rt + T / 256, 4, nb, bid, total_rt, (const char*)(ws + WS_WGU), (size_t)1024 * D, (const char*)(ws + WS_WSGU), lds};
        S.setup((const int*)(ws + WS_LTOK));
        pg8::EpiGUF E{ws + WS_ACT};
        pg8::gemm_phase<pg8::EpiGUF, SchedGU, true, false, true>(lds, S, E, -1);
        conv_down_queue(p, lds, xbw + 2);
    }
    SEAM(12);
    if (IN(13)) { LOADP(); unsigned char* ws = p.ws;
        const unsigned* ctl = (const unsigned*)(ws + WS_CTL);
        const int total_rt = pg8::moe_base_tables(ctl, lds) / 256;
        typedef pg8::MoeSched<false, true, 125, 122> SchedDn;
        SchedDn S{(const bf16*)(ws + WS_ACT), DEXP, DEXP, DEXP, total_rt + T / 256, 8, nb, bid, total_rt, (const char*)(ws + WS_WD), (size_t)D * DEXP, (const char*)(ws + WS_WSD), lds};
        S.setup(nullptr);
        pg8::EpiDownF E{ws + WS_Y, (const float*)(ws + WS_LW), lds};
        pg8::gemm_phase<pg8::EpiDownF, SchedDn, true, false, true>(lds, S, E, -1);
    }
    SEAM(13);
    if (IN(14)) { LOADP(); ph_combine(p.out, p.final_w, p.ws, lds, bid, nb); }
#undef IN
}

extern "C" void kernel_launch(void* const* d_in, const int* in_sizes, int n_in, void* d_out, int out_size, void* d_ws, size_t ws_size, hipStream_t stream) {
    static int grid = 0;
    if (grid == 0) {
        if (n_in != 23 || out_size != T * D || ws_size < WS_END) { fprintf(stderr, "kernel_launch: unexpected shapes (n_in %d out %d ws %zu need %zu)\n", n_in, out_size, ws_size, (size_t)WS_END); grid = -1; return; }
        if (hipFuncSetAttribute((const void*)mk, hipFuncAttributeMaxDynamicSharedMemorySize, LDS_BYTES) != hipSuccess) { fprintf(stderr, "hipFuncSetAttribute failed\n"); grid = -1; return; }
        int dev = 0, cus = 0; hipGetDevice(&dev); hipDeviceGetAttribute(&cus, hipDeviceAttributeMultiprocessorCount, dev);
        grid = cus > 0 ? cus : 256;
    }
    if (grid < 0) return;
    hipMemsetAsync((char*)d_ws + WS_CTL, 0, CTL_ZERO_BYTES, stream);
    Params p{};
    const float** pp = (const float**)&p;
    for (int i = 0; i < 23; ++i) pp[i] = (const float*)d_in[i];
    p.out = (float*)d_out; p.ws = (unsigned char*)d_ws;
    hipLaunchKernelGGL(mk, dim3(grid), dim3(NTHREADS), LDS_BYTES, stream, p);
}
```
